# Optimizing an MI355X kernel written in HIP

```python
import math
import jax, jax.numpy as jnp
from jax import lax
import numpy as np


D_MODEL = 1024
BATCH = 1
SEQ = 16384
DEPTH = 2
DEC_BATCH = 2
DEC_SEQ = 16384
PAST_LEN = 128

HEAD_DIM = 64
CONV_CH = 384
CONV_WIDTH = 3
DIFF_HEADS = 4
DIFF_QK_DIM = 32
DIFF_V_DIM = 2 * DIFF_QK_DIM
DIL_HEADS = 6
DIL_PAIRS = ((128, 1), (512, 4), (2048, 16))
DIL_HALF = 64
N_BUCKETS = 32
MAX_DISTANCE = 1024
D_FF = 2816
Q_BLOCK = 128
EPS = 1e-6
MIX_WIDTH = CONV_CH + DIFF_HEADS * DIFF_V_DIM + DIL_HEADS * HEAD_DIM
W_CONV = 3 * CONV_CH
W_DIFF_QK = DIFF_HEADS * 2 * DIFF_QK_DIM
W_DIFF_V = DIFF_HEADS * DIFF_V_DIM
W_DIL = DIL_HEADS * HEAD_DIM
IN_WIDTH = W_CONV + 2 * W_DIFF_QK + W_DIFF_V + 3 * W_DIL
SPLITS = (CONV_CH, 2 * CONV_CH, W_CONV,
          W_CONV + W_DIFF_QK, W_CONV + 2 * W_DIFF_QK, W_CONV + 2 * W_DIFF_QK + W_DIFF_V,
          W_CONV + 2 * W_DIFF_QK + W_DIFF_V + W_DIL, W_CONV + 2 * W_DIFF_QK + W_DIFF_V + 2 * W_DIL)

kernel_name = "hybrid_parallel_encoder_two_batches"


def rms_norm(x, g):
    xf = x.astype(jnp.float32)
    y = xf * lax.rsqrt(jnp.mean(xf * xf, axis=-1, keepdims=True) + EPS)
    return (y * g.astype(jnp.float32)).astype(x.dtype)


def rel_bucket(rel):
    nb = N_BUCKETS // 2
    max_exact = nb // 2
    ret = jnp.where(rel > 0, nb, 0)
    n = jnp.abs(rel)
    nf = jnp.maximum(n, 1).astype(jnp.float32)
    large = max_exact + (jnp.log(nf / max_exact) / math.log(MAX_DISTANCE / max_exact)
                         * (nb - max_exact)).astype(jnp.int32)
    large = jnp.minimum(large, nb - 1)
    return ret + jnp.where(n < max_exact, n, large)


def swiglu(h, w_gu, w_down):
    g, u = jnp.split(h @ w_gu, 2, axis=-1)
    return (jax.nn.silu(g) * u) @ w_down


def short_conv(u, w):
    c = u.shape[-1]
    return lax.conv_general_dilated(u, w[:, None, :].astype(u.dtype), window_strides=(1,),
                                    padding=((CONV_WIDTH // 2, CONV_WIDTH // 2),),
                                    dimension_numbers=('NWC', 'WIO', 'NWC'), feature_group_count=c)


def diff_attention(q, k, v, bias_tab, lam, lam_init, sub_g):
    b, s_len, h, _, dq = q.shape
    dv = v.shape[-1]
    nblk = s_len // Q_BLOCK
    qb = q.reshape(b, nblk, Q_BLOCK, h, 2, dq).swapaxes(0, 1)
    kpos = jnp.arange(s_len)

    def block(args):
        qblk, i = args
        qpos = i * Q_BLOCK + jnp.arange(Q_BLOCK)
        bias = bias_tab[rel_bucket(kpos[None, :] - qpos[:, None])].astype(jnp.float32)
        s = jnp.einsum('bqhcd,bkhcd->bchqk', qblk, k).astype(jnp.float32) \
            + jnp.transpose(bias, (2, 0, 1))[None, None]
        p = jax.nn.softmax(s, axis=-1)
        w = p[:, 0] - lam * p[:, 1]
        return jnp.einsum('bhqk,bkhd->bqhd', w.astype(v.dtype), v)

    out = lax.map(block, (qb, jnp.arange(nblk)))
    out = out.swapaxes(0, 1).reshape(b, s_len, h, dv)
    out = rms_norm(out, sub_g) * (1.0 - lam_init)
    return out.reshape(b, s_len, h * dv)


def dilated_attention(q, k, v, bias_tab):
    b, s_len, h, d = q.shape
    nblk = s_len // Q_BLOCK
    m = jnp.arange(-DIL_HALF, DIL_HALF + 1)
    offs = [m * r for (_, r) in DIL_PAIRS]
    biases = [bias_tab[rel_bucket(o)].T.astype(jnp.float32) for o in offs]
    qb = q.reshape(b, nblk, Q_BLOCK, h, d).swapaxes(0, 1)

    def block(args):
        qblk, i = args
        qpos = i * Q_BLOCK + jnp.arange(Q_BLOCK)
        outs, lses = [], []
        for off, bias in zip(offs, biases):
            idx = qpos[:, None] + off[None, :]
            valid = (idx >= 0) & (idx < s_len)
            idx = jnp.clip(idx, 0, s_len - 1)
            kg = k[:, idx]
            vg = v[:, idx]
            s = jnp.einsum('bqhd,bqjhd->bhqj', qblk, kg).astype(jnp.float32) + bias[None, :, None, :]
            s = jnp.where(valid[None, None], s, -jnp.inf)
            lse = jax.nn.logsumexp(s, axis=-1, keepdims=True)
            p = jnp.exp(s - lse)
            outs.append(jnp.einsum('bhqj,bqjhd->bqhd', p.astype(v.dtype), vg).astype(jnp.float32))
            lses.append(lse[..., 0])
        alpha = jax.nn.softmax(jnp.stack(lses), axis=0)
        alpha = jnp.swapaxes(alpha, 2, 3)[..., None]
        return jnp.sum(alpha * jnp.stack(outs), axis=0).astype(v.dtype)

    out = lax.map(block, (qb, jnp.arange(nblk)))
    return out.swapaxes(0, 1).reshape(b, s_len, h * d)


def trunk(x, p):
    b, s_len, _ = x.shape
    for l in range(DEPTH):
        lam_init = 0.8 - 0.6 * math.exp(-0.3 * l)
        x = x + 0.5 * swiglu(rms_norm(x, p['ffn1_norm'][l]), p['ffn1_w_gu'][l], p['ffn1_w_down'][l])
        h = rms_norm(x, p['mix_norm'][l])
        proj = h @ p['w_in'][l]
        (u, bg, cg, dq, dk, dv, lq, lk, lv) = jnp.split(proj, SPLITS, axis=-1)
        y_a = bg * short_conv(cg * u, p['conv_w'][l])
        dq = rms_norm(dq.reshape(b, s_len, DIFF_HEADS, 2, DIFF_QK_DIM), p['diff_q_norm'][l]) * (DIFF_QK_DIM ** -0.5)
        dk = rms_norm(dk.reshape(b, s_len, DIFF_HEADS, 2, DIFF_QK_DIM), p['diff_k_norm'][l])
        dv = dv.reshape(b, s_len, DIFF_HEADS, DIFF_V_DIM)
        lq1 = p['lambda_q1'][l].astype(jnp.float32)
        lk1 = p['lambda_k1'][l].astype(jnp.float32)
        lq2 = p['lambda_q2'][l].astype(jnp.float32)
        lk2 = p['lambda_k2'][l].astype(jnp.float32)
        lam = jnp.exp(jnp.sum(lq1 * lk1)) - jnp.exp(jnp.sum(lq2 * lk2)) + lam_init
        y_b = diff_attention(dq, dk, dv, p['rel_bias'][:, :DIFF_HEADS], lam, lam_init, p['diff_sub_norm'][l])
        lq = rms_norm(lq.reshape(b, s_len, DIL_HEADS, HEAD_DIM), p['dil_q_norm'][l]) * (HEAD_DIM ** -0.5)
        lk = rms_norm(lk.reshape(b, s_len, DIL_HEADS, HEAD_DIM), p['dil_k_norm'][l])
        lv = lv.reshape(b, s_len, DIL_HEADS, HEAD_DIM)
        y_c = dilated_attention(lq, lk, lv, p['rel_bias'][:, DIFF_HEADS:])
        x = x + jnp.concatenate([y_a, y_b.astype(x.dtype), y_c], axis=-1) @ p['w_out'][l]
        x = x + 0.5 * swiglu(rms_norm(x, p['ffn2_norm'][l]), p['ffn2_w_gu'][l], p['ffn2_w_down'][l])
        x = rms_norm(x, p['final_norm'][l])
    return x


def setup_inputs(seed: int = 0) -> dict:
    key = jax.random.key(seed)
    ks = jax.random.split(key, 24)
    f32 = jnp.float32

    def nrm(k, shape, scale):
        return jax.random.normal(k, shape, f32) * scale

    def gain(k, shape):
        return 1.0 + 0.02 * jax.random.normal(k, shape, f32)

    return {
        'x_prompt': nrm(ks[0], (BATCH, SEQ, D_MODEL), 1.0),
        'x_sample': nrm(ks[1], (DEC_BATCH, DEC_SEQ, D_MODEL), 1.0),
        'ffn1_norm': gain(ks[2], (DEPTH, D_MODEL)),
        'ffn1_w_gu': nrm(ks[3], (DEPTH, D_MODEL, 2 * D_FF), D_MODEL ** -0.5),
        'ffn1_w_down': nrm(ks[4], (DEPTH, D_FF, D_MODEL), D_FF ** -0.5),
        'mix_norm': gain(ks[5], (DEPTH, D_MODEL)),
        'w_in': nrm(ks[6], (DEPTH, D_MODEL, IN_WIDTH), D_MODEL ** -0.5),
        'conv_w': nrm(ks[7], (DEPTH, CONV_WIDTH, CONV_CH), CONV_WIDTH ** -0.5),
        'diff_q_norm': gain(ks[8], (DEPTH, DIFF_QK_DIM)),
        'diff_k_norm': gain(ks[9], (DEPTH, DIFF_QK_DIM)),
        'lambda_q1': nrm(ks[10], (DEPTH, DIFF_QK_DIM), 0.1),
        'lambda_k1': nrm(ks[11], (DEPTH, DIFF_QK_DIM), 0.1),
        'lambda_q2': nrm(ks[12], (DEPTH, DIFF_QK_DIM), 0.1),
        'lambda_k2': nrm(ks[13], (DEPTH, DIFF_QK_DIM), 0.1),
        'diff_sub_norm': gain(ks[14], (DEPTH, DIFF_V_DIM)),
        'dil_q_norm': gain(ks[15], (DEPTH, HEAD_DIM)),
        'dil_k_norm': gain(ks[16], (DEPTH, HEAD_DIM)),
        'w_out': nrm(ks[17], (DEPTH, MIX_WIDTH, D_MODEL), MIX_WIDTH ** -0.5),
        'ffn2_norm': gain(ks[18], (DEPTH, D_MODEL)),
        'ffn2_w_gu': nrm(ks[19], (DEPTH, D_MODEL, 2 * D_FF), D_MODEL ** -0.5),
        'ffn2_w_down': nrm(ks[20], (DEPTH, D_FF, D_MODEL), D_FF ** -0.5),
        'final_norm': gain(ks[21], (DEPTH, D_MODEL)),
        'rel_bias': nrm(ks[22], (N_BUCKETS, DIFF_HEADS + DIL_HEADS), 0.2),
    }


def reference(x_prompt, x_sample, ffn1_norm, ffn1_w_gu, ffn1_w_down, mix_norm, w_in, conv_w,
              diff_q_norm, diff_k_norm, lambda_q1, lambda_k1, lambda_q2, lambda_k2, diff_sub_norm,
              dil_q_norm, dil_k_norm, w_out, ffn2_norm, ffn2_w_gu, ffn2_w_down, final_norm, rel_bias):
    p = dict(ffn1_norm=ffn1_norm, ffn1_w_gu=ffn1_w_gu, ffn1_w_down=ffn1_w_down, mix_norm=mix_norm,
             w_in=w_in, conv_w=conv_w, diff_q_norm=diff_q_norm, diff_k_norm=diff_k_norm,
             lambda_q1=lambda_q1, lambda_k1=lambda_k1, lambda_q2=lambda_q2, lambda_k2=lambda_k2,
             diff_sub_norm=diff_sub_norm, dil_q_norm=dil_q_norm, dil_k_norm=dil_k_norm, w_out=w_out,
             ffn2_norm=ffn2_norm, ffn2_w_gu=ffn2_w_gu, ffn2_w_down=ffn2_w_down, final_norm=final_norm,
             rel_bias=rel_bias)
    y_prompt = trunk(x_prompt, p)
    y_sample = trunk(x_sample, p)
    return (y_prompt, y_sample)
```

```cpp
#include <hip/hip_runtime.h>
#include <hip/hip_cooperative_groups.h>
#include <cstdio>
#include <cstdint>
namespace cg = cooperative_groups;

#define LAS __attribute__((address_space(3)))
#define GAS __attribute__((address_space(1)))
typedef unsigned short bf16_t;
typedef short bf16x8 __attribute__((ext_vector_type(8)));
typedef short s16x4 __attribute__((ext_vector_type(4)));
typedef float f32x4 __attribute__((ext_vector_type(4)));
typedef float f32x16 __attribute__((ext_vector_type(16)));
typedef unsigned u32x4 __attribute__((ext_vector_type(4)));
typedef unsigned u32x2 __attribute__((ext_vector_type(2)));

constexpr int SEQ = 16384, NSEQ = 3, M = NSEQ * SEQ, D = 1024, FF = 2816, NIN = 3072, DEPTH = 2;
constexpr float EPS = 1e-6f, LOG2E = 1.4426950408889634f;
constexpr int PC_BG = 0, PC_DQ = 384, PC_LQ = 640, PC_U = 1024, PC_CG = 1408, PC_DK = 1792, PC_DV = 2048, PC_LK = 2304, PC_LV = 2688;
constexpr size_t WO_GU1 = 0, WO_D1 = 5767168, WO_IN = 8650752, WO_OUT = 11796480, WO_GU2 = 12845056, WO_D2 = 18612224, W_LAYER = 21495808;
constexpr size_t MiB = 1u << 20;
constexpr size_t WS_SS1 = 0;
constexpr size_t WS_CTL = 1 * MiB, CTL_BYTES = 65536;
constexpr size_t WS_PAR = 768 * 1024;
constexpr int P_CONV = 0, P_DQN = 2304, P_DKN = 2368, P_LQ1 = 2432, P_LK1 = 2496, P_LQ2 = 2560, P_LK2 = 2624, P_SUBN = 2688, P_LQN = 2816, P_LKN = 2944, P_FIN = 3072, P_RB = 5120;
constexpr size_t WS_W = 2 * MiB, WS_XB = 84 * MiB, WS_R = 180 * MiB, WS_SSP2 = 468 * MiB, WS_SSP3 = 472 * MiB, WS_SSPA = 476 * MiB, WS_SSPB = 480 * MiB, WS_END = 484 * MiB;
constexpr int LDS_BYTES = 136192, LDS_BAR_OFF = 135168;
constexpr int TDIFF_OFF = 65536, TDIFF_STRIDE = 1472, TDIL_OFF = TDIFF_OFF + 4 * TDIFF_STRIDE * 4, TDIL_STRIDE = 1792, MISC_OFF = TDIL_OFF + 6 * TDIL_STRIDE * 4;
constexpr int DOFF = 720;

typedef float f32x2_t __attribute__((ext_vector_type(2))); typedef __bf16 bf16x2_t __attribute__((ext_vector_type(2)));
__device__ __forceinline__ unsigned cvt_pk_bf16(float lo, float hi) { f32x2_t v = {lo, hi}; bf16x2_t b = __builtin_convertvector(v, bf16x2_t); return __builtin_bit_cast(unsigned, b); }
__device__ __forceinline__ float bf2f(unsigned short b) { return __uint_as_float(((unsigned)b) << 16); }
__device__ __forceinline__ float wave_sum(float v) {
#pragma unroll
    for (int o = 1; o < 64; o <<= 1) v += __shfl_xor(v, o);
    return v;
}
__device__ __forceinline__ float wave_max(float v) {
#pragma unroll
    for (int o = 1; o < 64; o <<= 1) v = fmaxf(v, __shfl_xor(v, o));
    return v;
}

namespace pg8 {
constexpr int BM = 256, BK = 64, HALF = 128, HTB = HALF * BK * 2, STAGE_BYTES = 8 * HTB, NXCD = 8, WGM = 8;
__host__ __device__ __forceinline__ int lds_byte(int r, int c) { const int st = (r >> 4) * 2 + (c >> 5), rr = r & 15, cc = c & 31, ob = rr * 64 + cc * 2; return st * 1024 + (ob ^ (((ob >> 9) & 1) << 5)); }
__host__ __device__ __forceinline__ void stage_rc(int b, int& R, int& C) { const int st = b / 1024, sb = b % 1024, swz = sb ^ (((sb >> 9) & 1) << 5); R = (st >> 1) * 16 + swz / 64; C = (st & 1) * 32 + (swz % 64) / 2; }
__host__ __device__ __forceinline__ int perm32(int rho) { const int n = rho >> 4, i = rho & 15; return 8 * (i >> 2) + 4 * n + (i & 3); }

struct Unit { int pm, pn; };
struct Gemm { const bf16_t* A; const bf16_t* Bt; int M, N, K, lda; };

struct StaticOrder {
    int nM, nN, nwg, G, c;
    __device__ void init(int M_, int N_, int G_, int c_) { nM = M_ / BM; nN = N_ / BM; nwg = nM * nN; G = G_; c = c_; }
    __device__ bool next(int i, Unit& u) const {
        const long L = (long)i * G + c; if (L >= nwg) return false;
        int wgid = (int)L; { const int q = nwg / NXCD, r = nwg % NXCD, xcd = wgid % NXCD, off = wgid / NXCD; wgid = (xcd < r ? xcd * (q + 1) : r * (q + 1) + (xcd - r) * q) + off; }
        const int nig = WGM * nN, gid = wgid / nig, fm = gid * WGM, gsz = (nM - fm) < WGM ? (nM - fm) : WGM;
        u.pm = fm + ((wgid % nig) % gsz); u.pn = (wgid % nig) / gsz; return true;
    }
};


template <int NP> __device__ __forceinline__ float row_ss(const float* ss, int row) {
    if (NP == 1) return ss[row];
    const f32x4* p = (const f32x4*)(ss + (size_t)row * 16);
    const f32x4 a = p[0], b = p[1], c = p[2], d = p[3];
    return ((a[0] + a[1]) + (a[2] + a[3])) + ((b[0] + b[1]) + (b[2] + b[3])) + ((c[0] + c[1]) + (c[2] + c[3])) + ((d[0] + d[1]) + (d[2] + d[3]));
}
template <int NP> struct EpiSwiGLU {
    bf16_t* H; const float* ss; const float* ssb;
    __device__ __forceinline__ void operator()(const f32x4 (&acc)[2][2][4][2], const Unit& u, int wr, int wc, int fr, int fq) const {
        const int row0 = u.pm * BM + wr * 64 + fr, col0 = u.pn * 128 + wc * 32 + 8 * fq;
#pragma unroll
        for (int ai = 0; ai < 2; ++ai)
#pragma unroll
            for (int m = 0; m < 4; ++m) {
                const int row = row0 + ai * HALF + m * 16;
                float rs;
                if (NP == 32) { const float r0 = __builtin_amdgcn_rsqf(row_ss<16>(ss, row) * (1.0f / 1024.0f) + EPS); rs = r0 * __builtin_amdgcn_rsqf(r0 * r0 * row_ss<16>(ssb, row) * (1.0f / 1024.0f) + EPS); }
                else rs = __builtin_amdgcn_rsqf(row_ss<(NP == 32 ? 16 : NP)>(ss, row) * (1.0f / 1024.0f) + EPS);
                float h[8];
#pragma unroll
                for (int n = 0; n < 2; ++n)
#pragma unroll
                    for (int i = 0; i < 4; ++i) {
                        const float g = acc[ai][0][m][n][i] * rs, uu = acc[ai][1][m][n][i] * rs;
                        const float e = __builtin_amdgcn_exp2f(-g * LOG2E);
                        h[n * 4 + i] = g * __builtin_amdgcn_rcpf(1.0f + e) * uu;
                    }
                u32x4 w; w.x = cvt_pk_bf16(h[0], h[1]); w.y = cvt_pk_bf16(h[2], h[3]); w.z = cvt_pk_bf16(h[4], h[5]); w.w = cvt_pk_bf16(h[6], h[7]);
                *(u32x4*)(H + (size_t)row * FF + col0) = w;
                asm volatile("" ::: "memory");
            }
    }
};

template <int MODE> struct EpiResid {
    bf16_t* xb; float* ss; float alpha; float* ss2; const float* ssin; const float* gf;
    __device__ __forceinline__ void operator()(const f32x4 (&acc)[2][2][4][2], const Unit& u, int wr, int wc, int fr, int fq) const {
        const int row0 = u.pm * BM + wr * 64 + fr, col0 = u.pn * BM + wc * 32 + 8 * fq;
        f32x4 gfa[2], gfb[2];
        if (MODE >= 2) {
#pragma unroll
            for (int bj = 0; bj < 2; ++bj) { gfa[bj] = *(const GAS f32x4*)(gf + col0 + bj * HALF); gfb[bj] = *(const GAS f32x4*)(gf + col0 + bj * HALF + 4); }
        }
#pragma unroll
        for (int ai = 0; ai < 2; ++ai)
#pragma unroll
            for (int m = 0; m < 4; ++m) {
                const int row = row0 + ai * HALF + m * 16;
                bf16_t* xr = xb + (size_t)row * D + col0;
                float sq = 0.f, sqb = 0.f, rin = 1.f;
                if (MODE == 3) rin = __builtin_amdgcn_rsqf(row_ss<16>(ssin, row) * (1.0f / 1024.0f) + EPS);
#pragma unroll
                for (int bj = 0; bj < 2; ++bj) {
                    const u32x4 o = *(const GAS u32x4*)(xr + bj * HALF);
                    f32x4 a = {__uint_as_float(o.x << 16), __uint_as_float(o.x & 0xffff0000u), __uint_as_float(o.y << 16), __uint_as_float(o.y & 0xffff0000u)};
                    f32x4 b = {__uint_as_float(o.z << 16), __uint_as_float(o.z & 0xffff0000u), __uint_as_float(o.w << 16), __uint_as_float(o.w & 0xffff0000u)};
                    if (MODE == 3) { a = a * rin * gfa[bj]; b = b * rin * gfb[bj]; }
                    a = a + acc[ai][bj][m][0] * alpha; b = b + acc[ai][bj][m][1] * alpha;
                    if (MODE >= 1) sq += (a[0] * a[0] + a[1] * a[1]) + (a[2] * a[2] + a[3] * a[3]) + (b[0] * b[0] + b[1] * b[1]) + (b[2] * b[2] + b[3] * b[3]);
                    if (MODE == 2) { const f32x4 ag = a * gfa[bj], bg = b * gfb[bj];
                        sqb += (ag[0] * ag[0] + ag[1] * ag[1]) + (ag[2] * ag[2] + ag[3] * ag[3]) + (bg[0] * bg[0] + bg[1] * bg[1]) + (bg[2] * bg[2] + bg[3] * bg[3]); }
                    u32x4 w; w.x = cvt_pk_bf16(a[0], a[1]); w.y = cvt_pk_bf16(a[2], a[3]); w.z = cvt_pk_bf16(b[0], b[1]); w.w = cvt_pk_bf16(b[2], b[3]);
                    *(GAS u32x4*)(xr + bj * HALF) = w;
                }
                if (MODE >= 1) { sq += __shfl_xor(sq, 16); sq += __shfl_xor(sq, 32); if (fq == 0) ss[(size_t)row * 16 + u.pn * 4 + wc] = sq; }
                if (MODE == 2) { sqb += __shfl_xor(sqb, 16); sqb += __shfl_xor(sqb, 32); if (fq == 0) ss2[(size_t)row * 16 + u.pn * 4 + wc] = sqb; }
                if (m & 1) asm volatile("" ::: "memory");
            }
    }
};

struct EpiWin {
    bf16_t* P; const float* ss; const float *dqn, *dkn, *lqn, *lkn;
    __device__ __forceinline__ void operator()(const f32x4 (&acc)[2][2][4][2], const Unit& u, int wr, int wc, int fr, int fq) const {
        const int g64 = 4 * u.pn + wc;
        const int row0 = u.pm * BM + wr * 64 + fr, col0 = 64 * g64 + 8 * fq;
        int type = 0; const float* gn = dqn; float sc = 1.f;
        if (g64 >= 6 && g64 < 10) { type = 1; gn = dqn; sc = 0.17677669529663687f * LOG2E; }
        else if (g64 >= 28 && g64 < 32) { type = 1; gn = dkn; sc = 1.f; }
        else if (g64 >= 10 && g64 < 16) { type = 2; gn = lqn; sc = 0.125f * LOG2E; }
        else if (g64 >= 36 && g64 < 42) { type = 2; gn = lkn; sc = 1.f; }
        float gv[2][8];
#pragma unroll
        for (int bj = 0; bj < 2; ++bj)
#pragma unroll
            for (int i = 0; i < 8; ++i) gv[bj][i] = (type == 0) ? 1.f : gn[(type == 2 ? 32 * bj : 0) + 8 * fq + i] * sc;
#pragma unroll
        for (int ai = 0; ai < 2; ++ai)
#pragma unroll
            for (int m = 0; m < 4; ++m) {
                const int row = row0 + ai * HALF + m * 16;
                const float rs = __builtin_amdgcn_rsqf(row_ss<16>(ss, row) * (1.0f / 1024.0f) + EPS);
                float v[2][8]; float q[2];
#pragma unroll
                for (int bj = 0; bj < 2; ++bj) { q[bj] = 0.f;
#pragma unroll
                    for (int n = 0; n < 2; ++n)
#pragma unroll
                        for (int i = 0; i < 4; ++i) { const float t = acc[ai][bj][m][n][i] * rs; v[bj][n * 4 + i] = t; q[bj] += t * t; } }
                if (type != 0) {
                    q[0] += __shfl_xor(q[0], 16); q[0] += __shfl_xor(q[0], 32);
                    q[1] += __shfl_xor(q[1], 16); q[1] += __shfl_xor(q[1], 32);
                    float n0, n1;
                    if (type == 1) { n0 = __builtin_amdgcn_rsqf(q[0] * (1.0f / 32.0f) + EPS); n1 = __builtin_amdgcn_rsqf(q[1] * (1.0f / 32.0f) + EPS); }
                    else { n0 = n1 = __builtin_amdgcn_rsqf((q[0] + q[1]) * (1.0f / 64.0f) + EPS); }
#pragma unroll
                    for (int i = 0; i < 8; ++i) { v[0][i] *= n0 * gv[0][i]; v[1][i] *= n1 * gv[1][i]; }
                }
#pragma unroll
                for (int bj = 0; bj < 2; ++bj) {
                    u32x4 w; w.x = cvt_pk_bf16(v[bj][0], v[bj][1]); w.y = cvt_pk_bf16(v[bj][2], v[bj][3]); w.z = cvt_pk_bf16(v[bj][4], v[bj][5]); w.w = cvt_pk_bf16(v[bj][6], v[bj][7]);
                    *(u32x4*)(P + (size_t)row * NIN + col0 + 32 * bj) = w;
                }
                asm volatile("" ::: "memory");
            }
    }
};

template <class Epi>
__device__ __forceinline__ void gemm_phase(LAS unsigned char* lds, const Gemm g, const StaticOrder& S, const Epi& E) {
    int tid_ = threadIdx.x; asm volatile("" : "+v"(tid_));
    const int tid = tid_, wid = __builtin_amdgcn_readfirstlane(tid >> 6), lane = tid & 63, wr = wid >> 2, wc = wid & 3, fr = lane & 15, fq = lane >> 4;
    const int K = g.K, nt = K / BK, lda = g.lda;
    unsigned voffA[2], voffB[2];
#pragma unroll
    for (int i = 0; i < 2; ++i) { int R, C; stage_rc(tid * 16 + i * 8192, R, C); const int Rb = (R & ~31) + perm32(R & 31);
        voffA[i] = (unsigned)(R * lda + C) * 2u; voffB[i] = (unsigned)(Rb * K + C) * 2u; }
    const unsigned kstep = (unsigned)(BK * 2);
    const unsigned hstepA = (unsigned)(HALF * lda * 2), hstepB = (unsigned)(HALF * K * 2);
    const size_t tstepA = 2 * (size_t)hstepA, tstepB = 2 * (size_t)hstepB;
    const unsigned ldsw = (unsigned)wid * 1024u;
    const int aoff = lds_byte(wr * 64 + fr, fq * 8), boff = lds_byte(wc * 32 + fr, fq * 8);
#define PG8_SA(b, h) (((b) * 2 + (h)) * HTB)
#define PG8_SB(b, h) ((4 + (b) * 2 + (h)) * HTB)
#define PG8_STAGE(bufoff, gbase, voff) do { _Pragma("unroll") for (int _i = 0; _i < 2; ++_i) \
        __builtin_amdgcn_global_load_lds((const unsigned*)((const char*)(gbase) + (voff)[_i]), (LAS unsigned*)(lds + (bufoff) + ldsw + _i * 8192), 16, 0, 0); } while (0)
#define PG8_LDA(dst, b, h) do { _Pragma("unroll") for (int m = 0; m < 4; ++m) _Pragma("unroll") for (int k = 0; k < 2; ++k) dst[m][k] = *(const LAS bf16x8*)(lds + PG8_SA(b, h) + aoff + m * 2048 + k * 1024); } while (0)
#define PG8_LDB(dst, b, h) do { _Pragma("unroll") for (int n = 0; n < 2; ++n) _Pragma("unroll") for (int k = 0; k < 2; ++k) dst[n][k] = *(const LAS bf16x8*)(lds + PG8_SB(b, h) + boff + n * 2048 + k * 1024); } while (0)
#define PG8_MMA(ai, bj, At, Bt) do { __builtin_amdgcn_s_setprio(1); _Pragma("unroll") for (int m = 0; m < 4; ++m) _Pragma("unroll") for (int n = 0; n < 2; ++n) _Pragma("unroll") for (int k = 0; k < 2; ++k) \
        acc[ai][bj][m][n] = __builtin_amdgcn_mfma_f32_16x16x32_bf16(Bt[n][k], At[m][k], acc[ai][bj][m][n], 0, 0, 0); __builtin_amdgcn_s_setprio(0); } while (0)
#define PG8_WAIT_V(n) asm volatile("s_waitcnt vmcnt(" #n ")" ::: "memory")
#define PG8_WAIT_L(n) asm volatile("s_waitcnt lgkmcnt(" #n ")" ::: "memory")
#define PG8_BAR __builtin_amdgcn_s_barrier()
#define PG8_SCHED __builtin_amdgcn_sched_barrier(0)
    Unit cur, nxt; int ui = 0;
    if (!S.next(0, cur)) return;
    f32x4 acc[2][2][4][2];
#pragma unroll
    for (int a = 0; a < 2; ++a)
#pragma unroll
        for (int b = 0; b < 2; ++b)
#pragma unroll
            for (int m = 0; m < 4; ++m)
#pragma unroll
                for (int n = 0; n < 2; ++n) acc[a][b][m][n] = (f32x4){0.f, 0.f, 0.f, 0.f};
    bf16x8 At[4][2], B0[2][2], B1[2][2];
    const char* cA = (const char*)g.A + (size_t)cur.pm * tstepA; const char* cB = (const char*)g.Bt + (size_t)cur.pn * tstepB;
    PG8_STAGE(PG8_SB(0, 0), cB, voffB); PG8_STAGE(PG8_SB(0, 1), cB + hstepB, voffB); PG8_STAGE(PG8_SA(0, 0), cA, voffA); PG8_STAGE(PG8_SA(0, 1), cA + hstepA, voffA);
    if (wr == 1) PG8_BAR;
    PG8_WAIT_V(2); PG8_BAR;
    PG8_STAGE(PG8_SB(1, 0), cB + kstep, voffB); PG8_STAGE(PG8_SA(1, 0), cA + kstep, voffA); PG8_STAGE(PG8_SB(1, 1), cB + hstepB + kstep, voffB);
    PG8_WAIT_V(6); PG8_BAR;
    for (;;) {
        const bool has_next = S.next(ui + 1, nxt);
        const char* nA = has_next ? (const char*)g.A + (size_t)nxt.pm * tstepA : cA; const char* nB = has_next ? (const char*)g.Bt + (size_t)nxt.pn * tstepB : cB;
        for (int t = 0; t < nt; t += 2) {
            const bool last = (t == nt - 2);
            const char* a1 = cA + (unsigned)(t + 1) * kstep;
            const char* a2 = last ? nA : cA + (unsigned)(t + 2) * kstep; const char* b2 = last ? nB : cB + (unsigned)(t + 2) * kstep;
            const char* a3 = a2 + kstep; const char* b3 = b2 + kstep;
            PG8_LDB(B0, 0, 0); PG8_LDB(B1, 0, 1); PG8_SCHED; PG8_LDA(At, 0, 0); PG8_STAGE(PG8_SA(1, 1), a1 + hstepA, voffA);
            PG8_WAIT_V(8); PG8_WAIT_L(0); PG8_BAR; PG8_MMA(0, 0, At, B0); PG8_MMA(0, 1, At, B1); PG8_BAR; PG8_SCHED;
            PG8_LDA(At, 0, 1); PG8_STAGE(PG8_SB(0, 0), b2, voffB); PG8_STAGE(PG8_SB(0, 1), b2 + hstepB, voffB); PG8_STAGE(PG8_SA(0, 0), a2, voffA);
            PG8_WAIT_V(8); PG8_WAIT_L(0); PG8_BAR; PG8_MMA(1, 0, At, B0); PG8_MMA(1, 1, At, B1); PG8_BAR; PG8_SCHED;
            PG8_LDB(B0, 1, 0); PG8_LDB(B1, 1, 1); PG8_SCHED; PG8_LDA(At, 1, 0); PG8_STAGE(PG8_SA(0, 1), a2 + hstepA, voffA);
            PG8_WAIT_V(8); PG8_WAIT_L(0); PG8_BAR; PG8_MMA(0, 0, At, B0); PG8_MMA(0, 1, At, B1); PG8_BAR; PG8_SCHED;
            PG8_LDA(At, 1, 1); PG8_STAGE(PG8_SB(1, 0), b3, voffB); PG8_STAGE(PG8_SB(1, 1), b3 + hstepB, voffB); PG8_STAGE(PG8_SA(1, 0), a3, voffA);
            PG8_WAIT_V(8); PG8_WAIT_L(0); PG8_BAR; PG8_MMA(1, 0, At, B0); PG8_MMA(1, 1, At, B1); PG8_BAR; PG8_SCHED;
        }
        if (wr == 0) PG8_BAR;
        E(acc, cur, wr, wc, fr, fq);
        if (!has_next) break;
#pragma unroll
        for (int a = 0; a < 2; ++a)
#pragma unroll
            for (int b = 0; b < 2; ++b)
#pragma unroll
                for (int m = 0; m < 4; ++m)
#pragma unroll
                    for (int n = 0; n < 2; ++n) acc[a][b][m][n] = (f32x4){0.f, 0.f, 0.f, 0.f};
        cur = nxt; cA = nA; cB = nB; ++ui;
        if (wr == 1) PG8_BAR;
    }
    PG8_WAIT_V(0);
    PG8_BAR;
#undef PG8_SA
#undef PG8_SB
#undef PG8_STAGE
#undef PG8_LDA
#undef PG8_LDB
#undef PG8_MMA
#undef PG8_WAIT_V
#undef PG8_WAIT_L
#undef PG8_BAR
#undef PG8_SCHED
}
}

__device__ __forceinline__ int map_gu(int nb) { const int r = nb * 32, pn = r >> 8, t = r & 255, bj = t >> 7; return bj * 88 + 4 * pn + ((t & 127) >> 5); }
__device__ __forceinline__ int map_win(int nb) {
    const int r = nb * 32, pn = r >> 8, t = r & 255, bj = t >> 7, wc = (t & 127) >> 5, p = 8 * pn + 2 * wc + bj;
    if (p < 12) return 12 + p; if (p < 20) return 36 + (p - 12); if (p < 32) return 60 + (p - 20); if (p < 44) return p - 32; if (p < 56) return 24 + (p - 44);
    if (p < 64) return 44 + (p - 56); if (p < 72) return 52 + (p - 64); return p;
}
__device__ __forceinline__ void wt_item(const float* W, int K, int N, const float* gain, const float* gain2, bf16_t* WT, int kb, int nb, int sg, LAS float* scr, int lane) {
    const int k0 = 64 * kb;
    f32x4 wv[8];
#pragma unroll
    for (int i = 0; i < 8; ++i) wv[i] = *(const GAS f32x4*)(W + (size_t)(k0 + 8 * i + (lane >> 3)) * N + 32 * sg + 4 * (lane & 7));
#pragma unroll
    for (int i = 0; i < 8; ++i) { const int kk = 8 * i + (lane >> 3); const float g = (gain ? gain[k0 + kk] : 1.f) * (gain2 ? gain2[k0 + kk] : 1.f); LAS float* d = scr + kk * 33 + 4 * (lane & 7);
        d[0] = wv[i][0] * g; d[1] = wv[i][1] * g; d[2] = wv[i][2] * g; d[3] = wv[i][3] * g; }
    asm volatile("s_waitcnt lgkmcnt(0)" ::: "memory");
    const int c = lane & 7;
#pragma unroll
    for (int j = 0; j < 4; ++j) { const int n = (lane >> 3) + 8 * j; const LAS float* s = scr + (8 * c) * 33 + n;
        u32x4 o; o.x = cvt_pk_bf16(s[0 * 33], s[1 * 33]); o.y = cvt_pk_bf16(s[2 * 33], s[3 * 33]); o.z = cvt_pk_bf16(s[4 * 33], s[5 * 33]); o.w = cvt_pk_bf16(s[6 * 33], s[7 * 33]);
        *(u32x4*)(WT + (size_t)(32 * nb + n) * K + k0 + 8 * c) = o; }
    asm volatile("s_waitcnt lgkmcnt(0)" ::: "memory");
}

struct Args { const float* in[23]; float* out; unsigned char* ws; };

__device__ __forceinline__ void weights_phase(const Args& a, LAS unsigned char* lds, int gw, int NGW, int wave, int lane) {
    LAS float* scr = (LAS float*)(lds + wave * 8704);
    bf16_t* Wb = (bf16_t*)(a.ws + WS_W);
    constexpr int I_GU = 16 * 176, I_D = 44 * 32, I_IN = 16 * 96, I_OUT = 16 * 32;
    constexpr int PER_LAYER = 2 * I_GU + 2 * I_D + I_IN + I_OUT;
    for (int it = gw; it < DEPTH * PER_LAYER; it += NGW) {
        const int l = it / PER_LAYER; int r = it - l * PER_LAYER;
        bf16_t* wl = Wb + (size_t)l * W_LAYER;
        if (r < I_GU) { const int kb = r / 176, nb = r % 176; wt_item(a.in[3] + (size_t)l * D * 2 * FF, D, 2 * FF, a.in[2] + l * D, l > 0 ? a.in[21] + (l - 1) * D : nullptr, wl + WO_GU1, kb, nb, map_gu(nb), scr, lane); continue; } r -= I_GU;
        if (r < I_D) { const int kb = r / 32, nb = r % 32; wt_item(a.in[4] + (size_t)l * FF * D, FF, D, nullptr, nullptr, wl + WO_D1, kb, nb, nb, scr, lane); continue; } r -= I_D;
        if (r < I_IN) { const int kb = r / 96, nb = r % 96; wt_item(a.in[6] + (size_t)l * D * NIN, D, NIN, a.in[5] + l * D, nullptr, wl + WO_IN, kb, nb, map_win(nb), scr, lane); continue; } r -= I_IN;
        if (r < I_OUT) { const int kb = r / 32, nb = r % 32; wt_item(a.in[17] + (size_t)l * D * D, D, D, nullptr, nullptr, wl + WO_OUT, kb, nb, nb, scr, lane); continue; } r -= I_OUT;
        if (r < I_GU) { const int kb = r / 176, nb = r % 176; wt_item(a.in[19] + (size_t)l * D * 2 * FF, D, 2 * FF, a.in[18] + l * D, nullptr, wl + WO_GU2, kb, nb, map_gu(nb), scr, lane); continue; } r -= I_GU;
        { const int kb = r / 32, nb = r % 32; wt_item(a.in[20] + (size_t)l * FF * D, FF, D, nullptr, nullptr, wl + WO_D2, kb, nb, nb, scr, lane); }
    }
}

template <bool FIRST>
__device__ __forceinline__ void norm_phase(const float* xp, const float* xs, float* out, unsigned char* ws, int mode, const float* gain, int gw, int NGW, int lane) {
    asm volatile("" : "+v"(lane));
    bf16_t* xb = (bf16_t*)(ws + WS_XB);
    float* ss1 = (float*)(ws + WS_SS1);
    for (int m = gw; m < M; m += NGW) {
        f32x4 v[4]; float s = 0.f;
        if (FIRST) {
            const float* src = (m < SEQ ? xp + (size_t)m * D : xs + (size_t)(m - SEQ) * D);
#pragma unroll
            for (int j = 0; j < 4; ++j) v[j] = *((const GAS f32x4*)src + lane + 64 * j);
        } else {
#pragma unroll
            for (int j = 0; j < 4; ++j) { const u32x2 w = *((const GAS u32x2*)(xb + (size_t)m * D) + lane + 64 * j);
                v[j] = (f32x4){__uint_as_float(w.x << 16), __uint_as_float(w.x & 0xffff0000u), __uint_as_float(w.y << 16), __uint_as_float(w.y & 0xffff0000u)}; }
        }
#pragma unroll
        for (int j = 0; j < 4; ++j) s += (v[j][0] * v[j][0] + v[j][1] * v[j][1]) + (v[j][2] * v[j][2] + v[j][3] * v[j][3]);
        s = wave_sum(s);
        if (!FIRST) {
            const float rs = __builtin_amdgcn_rsqf(s * (1.0f / 1024.0f) + EPS); float s2 = 0.f;
#pragma unroll
            for (int j = 0; j < 4; ++j) { const f32x4 gg = *((const GAS f32x4*)gain + lane + 64 * j); v[j] = v[j] * rs * gg; s2 += (v[j][0] * v[j][0] + v[j][1] * v[j][1]) + (v[j][2] * v[j][2] + v[j][3] * v[j][3]); }
            s = wave_sum(s2);
        }
        if (mode == 2) {
#pragma unroll
            for (int j = 0; j < 4; ++j) *((GAS f32x4*)(out + (size_t)m * D) + lane + 64 * j) = v[j];
        } else {
#pragma unroll
            for (int j = 0; j < 4; ++j) { u32x2 w; w.x = cvt_pk_bf16(v[j][0], v[j][1]); w.y = cvt_pk_bf16(v[j][2], v[j][3]); *((GAS u32x2*)(xb + (size_t)m * D) + lane + 64 * j) = w; }
            if (lane == 0) ss1[m] = s;
        }
    }
}

__device__ __forceinline__ int crow(int r, int hi) { return (r & 3) + 8 * (r >> 2) + 4 * hi; }
__device__ __forceinline__ int rel_bucket(int rel) {
    const int ret = rel > 0 ? 16 : 0; const int n = rel < 0 ? -rel : rel;
    if (n < 8) return ret + n;
    const float nf = (float)n;
    int large = 8 + (int)(logf(nf / 8.0f) / 4.852030263919617f * 8.0f);
    large = large < 15 ? large : 15;
    return ret + large;
}
typedef short v4i16_t __attribute__((ext_vector_type(4)));
__device__ __forceinline__ s16x4 vtr(const LAS unsigned char* p) { return __builtin_bit_cast(s16x4, __builtin_amdgcn_ds_read_tr16_b64_v4i16((LAS v4i16_t*)p)); }
#define MFMA32(a, b, c) __builtin_amdgcn_mfma_f32_32x32x16_bf16((a), (b), (c), 0, 0, 0)

__device__ __forceinline__ void attn_setup(const float* par, int l, LAS unsigned char* lds) {
    int tid_ = threadIdx.x; asm volatile("" : "+v"(tid_));
    const int tid = tid_, lane = tid & 63, wave = tid >> 6;
    LAS float* misc = (LAS float*)(lds + MISC_OFF);
    const float* rb = par + P_RB;
    if (wave == 0) {
        const float mq = wave_max(lane < 32 ? fabsf(par[P_DQN + l * 32 + lane]) : 0.f), mk = wave_max(lane < 32 ? fabsf(par[P_DKN + l * 32 + lane]) : 0.f);
        const float mlq = wave_max(fabsf(par[P_LQN + l * 64 + lane])), mlk = wave_max(fabsf(par[P_LKN + l * 64 + lane]));
        for (int hh = 0; hh < 10; ++hh) {
            const float bm = wave_max(lane < 32 ? fabsf(rb[lane * 10 + hh]) : 0.f);
            const float B = (hh < 4 ? 1.02f * 5.656854249f * mq * mk : 1.02f * 8.0f * mlq * mlk) + bm + 0.05f;
            if (lane == 0) misc[hh] = B;
        }
        const float s1 = wave_sum(lane < 32 ? par[P_LQ1 + l * 32 + lane] * par[P_LK1 + l * 32 + lane] : 0.f);
        const float s2 = wave_sum(lane < 32 ? par[P_LQ2 + l * 32 + lane] * par[P_LK2 + l * 32 + lane] : 0.f);
        const float lam_init = 0.8f - 0.6f * expf(-0.3f * (float)l);
        if (lane == 0) { misc[16] = expf(s1) - expf(s2) + lam_init; misc[17] = 1.0f - lam_init; }
    }
    __syncthreads();
    LAS float* td = (LAS float*)(lds + TDIFF_OFF);
    for (int i = tid; i < 4 * TDIFF_STRIDE; i += 512) { const int h = i / TDIFF_STRIDE, j = i % TDIFF_STRIDE; const int d = (j < 2 * DOFF + 1 ? j : 2 * DOFF) - DOFF;
        td[i] = (rb[rel_bucket(d) * 10 + h] - misc[h]) * LOG2E; }
    LAS float* tl = (LAS float*)(lds + TDIL_OFF);
    for (int i = tid; i < 6 * TDIL_STRIDE; i += 512) { const int hd = i / TDIL_STRIDE, j = i % TDIL_STRIDE; const int b = j < 1152 ? 0 : (j < 1560 ? 1 : 2), jj = j - (b == 0 ? 0 : (b == 1 ? 1152 : 1560));
        const int r = (b == 0) ? 1 : (b == 1 ? 4 : 16), f = 16 / r, mm = jj - (64 + 31 * f);
        tl[i] = (mm >= -64 && mm <= 64) ? (rb[rel_bucket(r * mm) * 10 + 4 + hd] - misc[4 + hd]) * LOG2E : -1e30f; }
    __syncthreads();
}

__device__ __forceinline__ void diff_unit(LAS unsigned char* lds, bf16_t* proj, const float* subg, int seq, int h, int qb, float lam, float osc) {
    int tid_ = threadIdx.x; asm volatile("" : "+v"(tid_));
    const int tid = tid_, lane = tid & 63, r32 = lane & 31, hi = lane >> 5, wid = __builtin_amdgcn_readfirstlane(tid >> 6);
    const size_t rowbase = (size_t)seq * SEQ;
    const int qw = qb * 256 + wid * 32;
    const bf16_t* Kg = proj + rowbase * NIN + PC_DK + h * 64;
    const bf16_t* Vg = proj + rowbase * NIN + PC_DV + h * 64;
    bf16_t* Qg = proj + (rowbase + qw) * NIN + PC_DQ + h * 64;
    bf16x8 qr[4];
#pragma unroll
    for (int j = 0; j < 4; ++j) qr[j] = *(const GAS bf16x8*)(Qg + (size_t)r32 * NIN + 16 * j + 8 * hi);
    const bf16_t* ksrc = Kg + (size_t)lane * NIN + wid * 8;
    const bf16_t* vsrc = Vg + (size_t)(16 * (wid & 3) + (lane >> 2)) * NIN + (wid >> 2) * 32 + (lane & 3) * 8;
    LAS unsigned char* kdst = lds + wid * 2048 + lane * 16;
    LAS unsigned char* vdst = lds + 32768 + (wid >> 2) * 8192 + (wid & 3) * 1024 + lane * 16;
    const LAS unsigned char* kp0 = lds + hi * 2048 + r32 * 16;
    const LAS unsigned char* vp0 = lds + 32768 + ((lane >> 4) & 1) * 32 + (lane & 3) * 8 + (4 * hi + ((lane & 15) >> 2)) * 64;
    const LAS float* Tb = (const LAS float*)(lds + TDIFF_OFF) + h * TDIFF_STRIDE;
    const float cL = Tb[0], cR = Tb[2 * DOFF];
    constexpr int NT = SEQ / 128;
    u32x4 kreg = *(const GAS u32x4*)ksrc, vreg = *(const GAS u32x4*)vsrc;
    *(LAS u32x4*)kdst = kreg; *(LAS u32x4*)vdst = vreg;
    kreg = *(const GAS u32x4*)(ksrc + (size_t)64 * NIN); vreg = *(const GAS u32x4*)(vsrc + (size_t)64 * NIN);
    *(LAS u32x4*)(kdst + 1024) = kreg; *(LAS u32x4*)(vdst + 4096) = vreg;
    __syncthreads();
    f32x16 o00 = {}, o01 = {}, o10 = {}, o11 = {};
    float l0 = 0.f, l1 = 0.f;
#define DIFF_EXP(SA, SB, PP, LL) do { float a0 = 0.f, a1 = 0.f; \
        _Pragma("unroll") for (int r = 0; r < 16; ++r) { SA[r] = __builtin_amdgcn_exp2f(SA[r]); SB[r] = __builtin_amdgcn_exp2f(SB[r]); a0 += SA[r]; a1 += SB[r]; } \
        LL += a0 + a1; \
        _Pragma("unroll") for (int i = 0; i < 4; ++i) { \
            PP[0][i] = cvt_pk_bf16(SA[2 * i], SA[2 * i + 1]); PP[1][i] = cvt_pk_bf16(SA[8 + 2 * i], SA[9 + 2 * i]); \
            PP[2][i] = cvt_pk_bf16(SB[2 * i], SB[2 * i + 1]); PP[3][i] = cvt_pk_bf16(SB[8 + 2 * i], SB[9 + 2 * i]); } } while (0)
#define DIFF_SUB(NEAR, H) do { \
        if (t + 1 < NT) { const size_t go = (size_t)((t + 1) * 128 + 64 * (H)) * NIN; kreg = *(const GAS u32x4*)(ksrc + go); vreg = *(const GAS u32x4*)(vsrc + go); }     \
        bf16x8 kf[8]; \
        _Pragma("unroll") for (int j = 0; j < 4; ++j) { kf[2 * j] = *(const LAS bf16x8*)(kp0 + slot + j * 4096 + (H) * 1024); kf[2 * j + 1] = *(const LAS bf16x8*)(kp0 + slot + j * 4096 + (H) * 1024 + 512); } \
        f32x16 sa0, sb0, sa1, sb1; \
        if (NEAR) { \
            const LAS float* tp = Tb + (t * 128 + 64 * (H) - qw - r32 + 4 * hi + DOFF); \
            f32x16 c0, c1; \
            _Pragma("unroll") for (int r = 0; r < 16; ++r) { c0[r] = tp[(r & 3) + 8 * (r >> 2)]; c1[r] = tp[32 + (r & 3) + 8 * (r >> 2)]; } \
            sa0 = MFMA32(kf[0], qr[0], c0); sb0 = MFMA32(kf[1], qr[0], c1); sa1 = MFMA32(kf[4], qr[2], c0); sb1 = MFMA32(kf[5], qr[2], c1); \
        } else { \
            const f32x16 z = {}; \
            sa0 = MFMA32(kf[0], qr[0], z); sb0 = MFMA32(kf[1], qr[0], z); sa1 = MFMA32(kf[4], qr[2], z); sb1 = MFMA32(kf[5], qr[2], z); \
        } \
        sa0 = MFMA32(kf[2], qr[1], sa0); sb0 = MFMA32(kf[3], qr[1], sb0); sa1 = MFMA32(kf[6], qr[3], sa1); sb1 = MFMA32(kf[7], qr[3], sb1); \
        u32x4 p0[4], p1[4]; \
        DIFF_EXP(sa0, sb0, p0, l0); \
        DIFF_EXP(sa1, sb1, p1, l1); \
        _Pragma("unroll") for (int ks = 0; ks < 4; ++ks) { \
            const LAS unsigned char* vq = vp0 + slot + (4 * (H) + ks) * 1024; \
            const s16x4 lo0 = vtr(vq), hi0 = vtr(vq + 512), lo1 = vtr(vq + 8192), hi1 = vtr(vq + 8192 + 512); \
            const bf16x8 v0 = (bf16x8){lo0[0], lo0[1], lo0[2], lo0[3], hi0[0], hi0[1], hi0[2], hi0[3]}; \
            const bf16x8 v1 = (bf16x8){lo1[0], lo1[1], lo1[2], lo1[3], hi1[0], hi1[1], hi1[2], hi1[3]}; \
            const bf16x8 pa0 = __builtin_bit_cast(bf16x8, p0[ks]), pa1 = __builtin_bit_cast(bf16x8, p1[ks]); \
            o00 = MFMA32(pa0, v0, o00); o01 = MFMA32(pa0, v1, o01); o10 = MFMA32(pa1, v0, o10); o11 = MFMA32(pa1, v1, o11); } \
        if (t + 1 < NT) { const int so = slot ^ 16384; *(LAS u32x4*)(kdst + so + (H) * 1024) = kreg; *(LAS u32x4*)(vdst + so + (H) * 4096) = vreg; } \
    } while (0)
#define DIFF_STEP(NEAR) do { \
        const int slot = (t & 1) * 16384; \
        _Pragma("unroll 1") for (int H = 0; H < 2; ++H) DIFF_SUB(NEAR, H); \
        __syncthreads(); \
    } while (0)
    int nL = (qw >= 686) ? ((qw - 686) >> 7) + 1 : 0, nR = (qw + 590 + 127) >> 7; nR = nR > NT ? NT : nR;
    int t = 0;
#pragma unroll 1
    for (; t < nL; ++t) DIFF_STEP(false);
    { const float f = __builtin_amdgcn_exp2f(cL); l0 *= f; l1 *= f;
#pragma unroll
      for (int r = 0; r < 16; ++r) { o00[r] *= f; o01[r] *= f; o10[r] *= f; o11[r] *= f; } }
#pragma unroll 1
    for (; t < nR; ++t) DIFF_STEP(true);
    { const float f = __builtin_amdgcn_exp2f(-cR); l0 *= f; l1 *= f;
#pragma unroll
      for (int r = 0; r < 16; ++r) { o00[r] *= f; o01[r] *= f; o10[r] *= f; o11[r] *= f; } }
#pragma unroll 1
    for (; t < NT; ++t) DIFF_STEP(false);
#undef DIFF_STEP
#undef DIFF_SUB
#undef DIFF_EXP
    l0 += __shfl_xor(l0, 32); l1 += __shfl_xor(l1, 32);
    const float g0 = subg[r32] * osc, g1 = subg[r32 + 32] * osc;
    LAS bf16_t* stg = (LAS bf16_t*)(lds + (wid < 4 ? 16384 : 49152) + (wid & 3) * 4096);
#pragma unroll
    for (int r = 0; r < 16; ++r) {
        const int row = crow(r, hi);
        const float i0 = __builtin_amdgcn_rcpf(__shfl(l0, row)), i1 = lam * __builtin_amdgcn_rcpf(__shfl(l1, row));
        const float va = o00[r] * i0 - o10[r] * i1, vb = o01[r] * i0 - o11[r] * i1;
        float q = va * va + vb * vb;
        q += __shfl_xor(q, 1); q += __shfl_xor(q, 2); q += __shfl_xor(q, 4); q += __shfl_xor(q, 8); q += __shfl_xor(q, 16);
        const float nr = __builtin_amdgcn_rsqf(q * (1.0f / 64.0f) + EPS);
        stg[row * 64 + r32] = (bf16_t)(cvt_pk_bf16(va * nr * g0, 0.f) & 0xffffu);
        stg[row * 64 + r32 + 32] = (bf16_t)(cvt_pk_bf16(vb * nr * g1, 0.f) & 0xffffu);
    }
    asm volatile("s_waitcnt lgkmcnt(0)" ::: "memory");
#pragma unroll
    for (int i = 0; i < 4; ++i) { const int row = i * 8 + (lane >> 3), ch = lane & 7; const u32x4 v = *(const LAS u32x4*)(stg + row * 64 + ch * 8); *(GAS u32x4*)(Qg + (size_t)row * NIN + ch * 8) = v; }
}

__device__ __forceinline__ void dil_unit(LAS unsigned char* lds, bf16_t* proj, int seq, int hd, int T0, int rho) {
    int tid_ = threadIdx.x; asm volatile("" : "+v"(tid_));
    const int tid = tid_, lane = tid & 63, r32 = lane & 31, hi = lane >> 5, wid = __builtin_amdgcn_readfirstlane(tid >> 6);
    bf16_t* base = proj + (size_t)seq * SEQ * NIN;
    LAS unsigned char* wbuf = lds + wid * 4096;
    const LAS unsigned char* vp = wbuf + ((lane >> 4) & 1) * 32 + (lane & 3) * 8 + (4 * hi + ((lane & 15) >> 2)) * 64;
    const int P0 = T0 + rho;
    bf16x8 qr[4];
#pragma unroll
    for (int ks = 0; ks < 4; ++ks) qr[ks] = *(const GAS bf16x8*)(base + (size_t)(P0 + 16 * r32) * NIN + PC_LQ + hd * 64 + 16 * ks + 8 * hi);
    f32x16 o0 = {}, o1 = {}; float l = 0.f;
    const bool bound = (T0 < 1024) || (T0 >= 15360);
#define DIL_PARAMS(i_) const int b_ = ((i_) >= 28) ? 2 : ((i_) >= 20 ? 1 : 0), g_ = (i_) - (b_ == 2 ? 28 : (b_ == 1 ? 20 : 0)), r_ = (b_ == 0) ? 1 : (b_ == 1 ? 4 : 16), kap0_ = 32 * g_ - 64
#define DIL_CLAMP(BOUND, x) ((BOUND) ? ((x) < 0 ? 0 : ((x) > SEQ - 1 ? SEQ - 1 : (x))) : (x))
#define DIL_LOADS(BOUND, i_, KF, VR) do { DIL_PARAMS(i_); \
        const int kpos = DIL_CLAMP(BOUND, P0 + r_ * (kap0_ + r32)); \
        _Pragma("unroll") for (int ks = 0; ks < 4; ++ks) KF[ks] = *(const GAS bf16x8*)(base + (size_t)kpos * NIN + PC_LK + hd * 64 + 16 * ks + 8 * hi); \
        _Pragma("unroll") for (int w = 0; w < 4; ++w) { const int vpos = DIL_CLAMP(BOUND, P0 + r_ * (kap0_ + 16 * (w & 1) + (lane >> 2))); \
            VR[w] = *(const GAS u32x4*)(base + (size_t)vpos * NIN + PC_LV + hd * 64 + (w >> 1) * 32 + (lane & 3) * 8); } } while (0)
#define DIL_LOOP(BOUND) do { \
    bf16x8 kfn[4]; u32x4 vrn[4]; \
    DIL_LOADS(BOUND, 0, kfn, vrn); \
    _Pragma("unroll 1") for (int i = 0; i < 33; ++i) { \
        bf16x8 kf[4]; u32x4 vr[4]; \
        _Pragma("unroll") for (int k = 0; k < 4; ++k) { kf[k] = kfn[k]; vr[k] = vrn[k]; } \
        { const int in_ = (i + 1 < 33) ? i + 1 : 32; DIL_LOADS(BOUND, in_, kfn, vrn); } \
        DIL_PARAMS(i); \
        const int f = 16 / r_; \
        const LAS float* tp = (const LAS float*)(lds + TDIL_OFF) + hd * TDIL_STRIDE + (b_ == 0 ? 0 : (b_ == 1 ? 1152 : 1560)) + (64 + 31 * f + 4 * hi - f * r32) + kap0_; \
        _Pragma("unroll") for (int w = 0; w < 4; ++w) *(LAS u32x4*)(wbuf + w * 1024 + lane * 16) = vr[w]; \
        f32x16 sc; \
        _Pragma("unroll") for (int rr = 0; rr < 16; ++rr) sc[rr] = tp[(rr & 3) + 8 * (rr >> 2)]; \
        _Pragma("unroll") for (int ks = 0; ks < 4; ++ks) sc = MFMA32(kf[ks], qr[ks], sc); \
        float p[16]; float a0 = 0.f, a1 = 0.f; \
        _Pragma("unroll") for (int rr = 0; rr < 16; rr += 2) { \
            float e0 = __builtin_amdgcn_exp2f(sc[rr]), e1 = __builtin_amdgcn_exp2f(sc[rr + 1]); \
            if (BOUND) { const int p0_ = P0 + r_ * (kap0_ + crow(rr, hi)), p1_ = P0 + r_ * (kap0_ + crow(rr + 1, hi)); e0 = (p0_ >= 0 && p0_ < SEQ) ? e0 : 0.f; e1 = (p1_ >= 0 && p1_ < SEQ) ? e1 : 0.f; } \
            p[rr] = e0; p[rr + 1] = e1; a0 += e0; a1 += e1; } \
        l += a0 + a1; \
        u32x4 pw0, pw1; \
        _Pragma("unroll") for (int k = 0; k < 4; ++k) { pw0[k] = cvt_pk_bf16(p[2 * k], p[2 * k + 1]); pw1[k] = cvt_pk_bf16(p[8 + 2 * k], p[9 + 2 * k]); } \
        asm volatile("s_waitcnt lgkmcnt(0)" ::: "memory"); \
        _Pragma("unroll") for (int ks = 0; ks < 2; ++ks) { \
            const s16x4 lo0 = vtr(vp + ks * 1024), hi0 = vtr(vp + ks * 1024 + 512); \
            const s16x4 lo1 = vtr(vp + 2048 + ks * 1024), hi1 = vtr(vp + 2048 + ks * 1024 + 512); \
            const bf16x8 v0 = (bf16x8){lo0[0], lo0[1], lo0[2], lo0[3], hi0[0], hi0[1], hi0[2], hi0[3]}; \
            const bf16x8 v1 = (bf16x8){lo1[0], lo1[1], lo1[2], lo1[3], hi1[0], hi1[1], hi1[2], hi1[3]}; \
            const bf16x8 pa = __builtin_bit_cast(bf16x8, ks == 0 ? pw0 : pw1); \
            o0 = MFMA32(pa, v0, o0); o1 = MFMA32(pa, v1, o1); } \
        asm volatile("s_waitcnt lgkmcnt(0)" ::: "memory"); \
    } } while (0)
    if (bound) DIL_LOOP(true); else DIL_LOOP(false);
#undef DIL_LOOP
#undef DIL_CLAMP
#undef DIL_LOADS
#undef DIL_PARAMS
    LAS bf16_t* stg = (LAS bf16_t*)wbuf;
    l += __shfl_xor(l, 32);
#pragma unroll
    for (int rr = 0; rr < 16; ++rr) {
        const int j = crow(rr, hi);
        const float il = __builtin_amdgcn_rcpf(__shfl(l, j));
        stg[j * 64 + r32] = (bf16_t)(cvt_pk_bf16(o0[rr] * il, 0.f) & 0xffffu);
        stg[j * 64 + r32 + 32] = (bf16_t)(cvt_pk_bf16(o1[rr] * il, 0.f) & 0xffffu);
    }
    asm volatile("s_waitcnt lgkmcnt(0)" ::: "memory");
#pragma unroll
    for (int i = 0; i < 4; ++i) { const int row = i * 8 + (lane >> 3), ch = lane & 7; const u32x4 v = *(const LAS u32x4*)(stg + row * 64 + ch * 8);
        *(GAS u32x4*)(base + (size_t)(P0 + 16 * row) * NIN + PC_LQ + hd * 64 + ch * 8) = v; }
    asm volatile("s_waitcnt lgkmcnt(0)" ::: "memory");
}

__device__ __forceinline__ void conv_phase(bf16_t* proj, const float* cw, int G) {
    int tid_ = threadIdx.x; asm volatile("" : "+v"(tid_));
    for (int item = blockIdx.x * 512 + tid_; item < M * 48; item += G * 512) {
        const int row = item / 48, ch = (item % 48) * 8, t = row % SEQ;
        const bf16_t* pr = proj + (size_t)row * NIN;
        float accv[8];
#pragma unroll
        for (int i = 0; i < 8; ++i) accv[i] = 0.f;
#pragma unroll
        for (int k = 0; k < 3; ++k) {
            const int tt = t + k - 1;
            if (tt < 0 || tt >= SEQ) continue;
            const bf16_t* p2 = pr + (ptrdiff_t)(k - 1) * NIN;
            const u32x4 uu = *(const u32x4*)(p2 + PC_U + ch), cc = *(const u32x4*)(p2 + PC_CG + ch);
            const f32x4 w0 = *(const f32x4*)(cw + k * 384 + ch), w1 = *(const f32x4*)(cw + k * 384 + ch + 4);
#pragma unroll
            for (int i = 0; i < 4; ++i) {
                const float ulo = __uint_as_float(uu[i] << 16), uhi = __uint_as_float(uu[i] & 0xffff0000u);
                const float clo = __uint_as_float(cc[i] << 16), chi = __uint_as_float(cc[i] & 0xffff0000u);
                const float wlo = (i < 2) ? w0[2 * i] : w1[2 * i - 4], whi = (i < 2) ? w0[2 * i + 1] : w1[2 * i - 3];
                accv[2 * i] += wlo * ulo * clo; accv[2 * i + 1] += whi * uhi * chi;
            }
        }
        const u32x4 bb = *(const u32x4*)(pr + PC_BG + ch);
        u32x4 o;
#pragma unroll
        for (int i = 0; i < 4; ++i) { const float blo = __uint_as_float(bb[i] << 16), bhi = __uint_as_float(bb[i] & 0xffff0000u); o[i] = cvt_pk_bf16(blo * accv[2 * i], bhi * accv[2 * i + 1]); }
        *(u32x4*)(proj + (size_t)row * NIN + PC_BG + ch) = o;
    }
}

__device__ __forceinline__ void attn_phase(unsigned char* ws, int l, LAS unsigned char* lds, int G) {
    bf16_t* proj = (bf16_t*)(ws + WS_R);
    const float* par = (const float*)(ws + WS_PAR);
    attn_setup(par, l, lds);
    const LAS float* misc = (const LAS float*)(lds + MISC_OFF);
    const float lam = misc[16], osc = misc[17];
    const int wid = __builtin_amdgcn_readfirstlane(threadIdx.x >> 6);
    const int bx = blockIdx.x;
    const int vb = (G % 8 == 0) ? (bx % 8) * (G / 8) + bx / 8 : bx;
    for (int u = vb; u < 768; u += G) {
        const int pair = u >> 6, qb = u & 63;
        diff_unit(lds, proj, par + P_SUBN + l * 64, pair >> 2, pair & 3, qb, lam, osc);
    }
    __syncthreads();
    for (int bu = vb; bu < 1152; bu += G) {
        const int sh = bu >> 6, rem = bu & 63, T0 = (rem >> 1) * 512, rho = (rem & 1) * 8 + wid;
        dil_unit(lds, proj, sh / 6, sh % 6, T0, rho);
    }
    conv_phase(proj, par + P_CONV + l * 3 * 384, G);
}


#define XB_TMO      128
#define XB_XCNT(j)  (256  + 64 * (j))
#define XB_XSUB(j)  (1280 + 64 * (j))
#define XB_XGEN(j)  (2304 + 64 * (j))
#define XB_TOP      3328
#define XB_TOPGEN   3392
#define XB_SPIN_CAP (1u << 22)
__device__ __forceinline__ unsigned xb_ld(unsigned* p)              { return __hip_atomic_load(p, __ATOMIC_RELAXED, __HIP_MEMORY_SCOPE_AGENT); }
__device__ __forceinline__ unsigned xb_add(unsigned* p, unsigned v) { return __hip_atomic_fetch_add(p, v, __ATOMIC_RELAXED, __HIP_MEMORY_SCOPE_AGENT); }
__device__ __forceinline__ unsigned xb_xcc_id() { return (unsigned)__builtin_amdgcn_s_getreg((3 << 11) | 20) & 0xFu; }
#define XB_SPIN(cond, bar) do { unsigned _sp = 0; while (cond) { __builtin_amdgcn_s_sleep(1); \
    if ((++_sp & 255u) == 0u) { if (xb_ld(&(bar)[XB_TMO])) break; if (_sp > XB_SPIN_CAP) { atomicAdd(&(bar)[XB_TMO], 1u); break; } } } } while (0)
struct XcdBarrier { unsigned* bar; unsigned x; volatile LAS unsigned* st; };
__device__ __forceinline__ XcdBarrier xcd_barrier_post(unsigned* bar, volatile LAS unsigned* st) {
    XcdBarrier b; b.bar = bar; b.x = xb_xcc_id(); b.st = st;
    if (threadIdx.x == 0) (void)xb_add(&bar[XB_XCNT(b.x)], 1u);
    return b;
}
__device__ __forceinline__ void xcd_barrier_complete(unsigned* bar, unsigned x, unsigned& nloc, unsigned& nx) {
    const unsigned G = gridDim.x * gridDim.y * gridDim.z;
    unsigned sum, cnt, mine, sp = 0u;
    for (;;) {
        sum = 0u; cnt = 0u; mine = 0u;
#pragma unroll
        for (unsigned j = 0; j < 16; ++j) { const unsigned c = xb_ld(&bar[XB_XCNT(j)]); sum += c; cnt += (c > 0u) ? 1u : 0u; mine = (j == x) ? c : mine; }
        if (sum == G) break;
        __builtin_amdgcn_s_sleep(1);
        if ((++sp & 255u) == 0u) { if (xb_ld(&bar[XB_TMO])) break; if (sp > XB_SPIN_CAP) { atomicAdd(&bar[XB_TMO], 1u); break; } }
    }
    nloc = mine > 0u ? mine : 1u; nx = cnt > 0u ? cnt : 1u;
}
__device__ __forceinline__ void xcd_barrier(const XcdBarrier& b) {
    asm volatile("s_waitcnt vmcnt(0)" ::: "memory");
    __syncthreads();
    int t0_ = threadIdx.x; asm volatile("" : "+v"(t0_));
    if (t0_ == 0) {
        unsigned* bar = b.bar;
        __builtin_amdgcn_s_waitcnt(0);
        unsigned nloc = b.st[0], nx = b.st[1];
        if (nloc == 0u) { xcd_barrier_complete(bar, b.x, nloc, nx); b.st[0] = nloc; b.st[1] = nx; }
        const unsigned old = xb_add(&bar[XB_XSUB(b.x)], 1u);
        const unsigned gen = old / nloc;
        if (old + 1u == (gen + 1u) * nloc) {
            __builtin_amdgcn_fence(__ATOMIC_RELEASE, "agent");
            asm volatile("s_waitcnt vmcnt(0)" ::: "memory");
            const unsigned og = xb_add(&bar[XB_TOP], 1u);
            const unsigned tg = og / nx;
            if (og + 1u == (tg + 1u) * nx) xb_add(&bar[XB_TOPGEN], 1u);
            else XB_SPIN(xb_ld(&bar[XB_TOPGEN]) == tg, bar);
            __builtin_amdgcn_fence(__ATOMIC_ACQUIRE, "agent");
            xb_add(&bar[XB_XGEN(b.x)], 1u);
            asm volatile("s_waitcnt vmcnt(0)" ::: "memory");
        } else {
            XB_SPIN(xb_ld(&bar[XB_XGEN(b.x)]) == gen, bar);
            __builtin_amdgcn_fence(__ATOMIC_ACQUIRE, "agent");
            asm volatile("s_waitcnt vmcnt(0)" ::: "memory");
        }
    }
    __syncthreads();
}
__global__ void __launch_bounds__(512) mk_fwd(Args a) {
    extern __shared__ __attribute__((aligned(16))) unsigned char lds_raw[];
    LAS unsigned char* lds = (LAS unsigned char*)lds_raw;
    cg::grid_group grid = cg::this_grid();
    if (threadIdx.x < 16) ((LAS unsigned*)(lds + LDS_BAR_OFF))[threadIdx.x] = 0u;
    __syncthreads();
    (void)xcd_barrier_post((unsigned*)(a.ws + WS_CTL), (volatile LAS unsigned*)(lds + LDS_BAR_OFF));
    grid.sync();
#define GRID_SYNC() do { unsigned char* w_ = wsb; asm volatile("" : "+s"(w_)); XcdBarrier b_; b_.bar = (unsigned*)(w_ + WS_CTL); b_.x = xb_xcc_id(); \
        b_.st = (volatile LAS unsigned*)(lds + LDS_BAR_OFF); xcd_barrier(b_); } while (0)
    unsigned char* wsb = a.ws;
    const int tid = threadIdx.x, lane = tid & 63, wave = __builtin_amdgcn_readfirstlane(tid >> 6);
    const int G = gridDim.x, gw = blockIdx.x * 8 + wave, NGW = G * 8;
    weights_phase(a, lds, gw, NGW, wave, lane);
    norm_phase<true>(a.in[0], a.in[1], a.out, a.ws, 0, nullptr, gw, NGW, lane);
    if (blockIdx.x == 0) {
        float* pw = (float*)(a.ws + WS_PAR);
#define CPY(off, src, n) for (int i = tid; i < (n); i += 512) pw[(off) + i] = (src)[i]
        CPY(P_CONV, a.in[7], 2304); CPY(P_DQN, a.in[8], 64); CPY(P_DKN, a.in[9], 64); CPY(P_LQ1, a.in[10], 64); CPY(P_LK1, a.in[11], 64); CPY(P_LQ2, a.in[12], 64); CPY(P_LK2, a.in[13], 64);
        CPY(P_SUBN, a.in[14], 128); CPY(P_LQN, a.in[15], 128); CPY(P_LKN, a.in[16], 128); CPY(P_FIN, a.in[21], 2048); CPY(P_RB, a.in[22], 320);
#undef CPY
    }
    unsigned char* ws = a.ws; float* xout = a.out;
    GRID_SYNC();
    asm volatile("" : "+s"(ws), "+s"(xout));
#define PHASE_PTRS() unsigned char* w = ws; asm volatile("" : "+s"(w)); bf16_t* Wb = (bf16_t*)(w + WS_W); bf16_t* xb = (bf16_t*)(w + WS_XB); bf16_t* R = (bf16_t*)(w + WS_R); \
        float* ss1 = (float*)(w + WS_SS1); float* ss2 = (float*)(w + WS_SSP2); float* ss3 = (float*)(w + WS_SSP3); const float* par = (const float*)(w + WS_PAR); \
        const bf16_t* wl = Wb + (size_t)l * W_LAYER; pg8::StaticOrder S; (void)xb; (void)R; (void)ss1; (void)ss2; (void)ss3; (void)par; (void)wl
#define LAYER(LL) do { constexpr int l = (LL); \
        { PHASE_PTRS(); pg8::Gemm g{xb, wl + WO_GU1, M, 2 * FF, D, D}; S.init(M, 2 * FF, G, blockIdx.x); \
          if constexpr (l == 0) { pg8::EpiSwiGLU<1> E{R, ss1, nullptr}; pg8::gemm_phase(lds, g, S, E); } \
          else { pg8::EpiSwiGLU<32> E{R, (const float*)(w + WS_SSPA), (const float*)(w + WS_SSPB)}; pg8::gemm_phase(lds, g, S, E); } } \
        GRID_SYNC(); \
        { PHASE_PTRS(); pg8::Gemm g{R, wl + WO_D1, M, D, FF, FF}; S.init(M, D, G, blockIdx.x); \
          if constexpr (l == 0) { pg8::EpiResid<1> E{xb, ss2, 0.5f, nullptr, nullptr, nullptr}; pg8::gemm_phase(lds, g, S, E); } \
          else { pg8::EpiResid<3> E{xb, ss2, 0.5f, nullptr, (const float*)(w + WS_SSPA), par + P_FIN + (l - 1) * D}; pg8::gemm_phase(lds, g, S, E); } } \
        GRID_SYNC(); \
        { PHASE_PTRS(); pg8::Gemm g{xb, wl + WO_IN, M, NIN, D, D}; S.init(M, NIN, G, blockIdx.x); \
          pg8::EpiWin E{R, ss2, par + P_DQN + l * 32, par + P_DKN + l * 32, par + P_LQN + l * 64, par + P_LKN + l * 64}; pg8::gemm_phase(lds, g, S, E); } \
        GRID_SYNC(); \
        { unsigned char* w = ws; asm volatile("" : "+s"(w)); attn_phase(w, l, lds, G); } \
        GRID_SYNC(); \
        { PHASE_PTRS(); pg8::Gemm g{R, wl + WO_OUT, M, D, D, NIN}; S.init(M, D, G, blockIdx.x); pg8::EpiResid<1> E{xb, ss3, 1.0f, nullptr, nullptr, nullptr}; pg8::gemm_phase(lds, g, S, E); } \
        GRID_SYNC(); \
        { PHASE_PTRS(); pg8::Gemm g{xb, wl + WO_GU2, M, 2 * FF, D, D}; S.init(M, 2 * FF, G, blockIdx.x); pg8::EpiSwiGLU<16> E{R, ss3, nullptr}; pg8::gemm_phase(lds, g, S, E); } \
        GRID_SYNC(); \
        { PHASE_PTRS(); pg8::Gemm g{R, wl + WO_D2, M, D, FF, FF}; S.init(M, D, G, blockIdx.x); \
          if constexpr (l + 1 < DEPTH) { pg8::EpiResid<2> E{xb, (float*)(w + WS_SSPA), 0.5f, (float*)(w + WS_SSPB), nullptr, par + P_FIN + l * D}; pg8::gemm_phase(lds, g, S, E); } \
          else { pg8::EpiResid<0> E{xb, ss3, 0.5f, nullptr, nullptr, nullptr}; pg8::gemm_phase(lds, g, S, E); } } \
        GRID_SYNC(); \
        if constexpr (l + 1 == DEPTH) { PHASE_PTRS(); norm_phase<false>(nullptr, nullptr, xout, w, 2, par + P_FIN + l * D, gw, NGW, lane); }     \
    } while (0)
    LAYER(0);
    LAYER(1);
#undef LAYER
}

extern "C" void kernel_launch(void* const* d_in, const int* in_sizes, int n_in, void* d_out, int out_size, void* d_ws, size_t ws_size, hipStream_t stream) {
    static int grid = 0;
    if (grid == 0) {
        if (n_in != 23 || out_size != M * D || ws_size < WS_END) { fprintf(stderr, "kernel_launch: unexpected shapes (n_in %d out %d ws %zu)\n", n_in, out_size, ws_size); grid = -1; return; }
        int dev = 0, cus = 0, per_cu = 0;
        hipGetDevice(&dev);
        hipDeviceGetAttribute(&cus, hipDeviceAttributeMultiprocessorCount, dev);
        hipFuncSetAttribute((const void*)mk_fwd, hipFuncAttributeMaxDynamicSharedMemorySize, LDS_BYTES);
        hipOccupancyMaxActiveBlocksPerMultiprocessor(&per_cu, (const void*)mk_fwd, 512, LDS_BYTES);
        if (per_cu < 1) per_cu = 1;
        grid = cus * per_cu;
    }
    if (grid < 0) return;
    if (hipMemsetAsync((char*)d_ws + WS_CTL, 0, CTL_BYTES, stream) != hipSuccess) { fprintf(stderr, "memset of control words failed\n"); return; }
    Args a{};
    for (int i = 0; i < 23; ++i) a.in[i] = (const float*)d_in[i];
    a.out = (float*)d_out; a.ws = (unsigned char*)d_ws;
    void* args[] = {&a};
    hipError_t e = hipLaunchCooperativeKernel((const void*)mk_fwd, dim3(grid), dim3(512), args, LDS_BYTES, stream);
    if (e != hipSuccess) fprintf(stderr, "cooperative launch failed: %s (grid %d)\n", hipGetErrorString(e), grid);
}
```

```cpp
#include <hip/hip_runtime.h>
#include <hip/hip_cooperative_groups.h>
#include <cstdio>
#include <cstdint>
namespace cg = cooperative_groups;

#define LAS __attribute__((address_space(3)))
#define GAS __attribute__((address_space(1)))
typedef unsigned short bf16_t;
typedef short bf16x8 __attribute__((ext_vector_type(8)));
typedef short s16x4 __attribute__((ext_vector_type(4)));
typedef float f32x4 __attribute__((ext_vector_type(4)));
typedef float f32x16 __attribute__((ext_vector_type(16)));
typedef unsigned u32x4 __attribute__((ext_vector_type(4)));
typedef unsigned u32x2 __attribute__((ext_vector_type(2)));

constexpr int SEQ = 16384, NSEQ = 3, M = NSEQ * SEQ, D = 1024, FF = 2816, NIN = 3072, DEPTH = 2;
constexpr float EPS = 1e-6f, LOG2E = 1.4426950408889634f;
constexpr int PC_BG = 0, PC_DQ = 384, PC_LQ = 640, PC_U = 1024, PC_CG = 1408, PC_DK = 1792, PC_DV = 2048, PC_LK = 2304, PC_LV = 2688;
constexpr size_t WO_GU1 = 0, WO_D1 = 5767168, WO_IN = 8650752, WO_OUT = 11796480, WO_GU2 = 12845056, WO_D2 = 18612224, W_LAYER = 21495808;
constexpr size_t MiB = 1u << 20;
constexpr size_t WS_SS1 = 0;
constexpr size_t WS_CTL = 1 * MiB, CTL_BYTES = 65536;
constexpr size_t WS_PAR = 768 * 1024;
constexpr int P_CONV = 0, P_DQN = 2304, P_DKN = 2368, P_LQ1 = 2432, P_LK1 = 2496, P_LQ2 = 2560, P_LK2 = 2624, P_SUBN = 2688, P_LQN = 2816, P_LKN = 2944, P_FIN = 3072, P_RB = 5120;
constexpr size_t WS_W = 2 * MiB, WS_XB = 84 * MiB, WS_R = 180 * MiB, WS_SSP2 = 468 * MiB, WS_SSP3 = 472 * MiB, WS_END = 476 * MiB;
constexpr int LDS_BYTES = 136192, LDS_BAR_OFF = 135168;
constexpr int TDIFF_OFF = 65536, TDIFF_STRIDE = 1472, TDIL_OFF = TDIFF_OFF + 4 * TDIFF_STRIDE * 4, TDIL_STRIDE = 1792, MISC_OFF = TDIL_OFF + 6 * TDIL_STRIDE * 4;
constexpr int DOFF = 720;

typedef float f32x2_t __attribute__((ext_vector_type(2))); typedef __bf16 bf16x2_t __attribute__((ext_vector_type(2)));
__device__ __forceinline__ unsigned cvt_pk_bf16(float lo, float hi) { f32x2_t v = {lo, hi}; bf16x2_t b = __builtin_convertvector(v, bf16x2_t); return __builtin_bit_cast(unsigned, b); }
__device__ __forceinline__ float bf2f(unsigned short b) { return __uint_as_float(((unsigned)b) << 16); }
__device__ __forceinline__ float wave_sum(float v) {
#pragma unroll
    for (int o = 1; o < 64; o <<= 1) v += __shfl_xor(v, o);
    return v;
}
__device__ __forceinline__ float wave_max(float v) {
#pragma unroll
    for (int o = 1; o < 64; o <<= 1) v = fmaxf(v, __shfl_xor(v, o));
    return v;
}

namespace pg8 {
constexpr int BM = 256, BK = 64, HALF = 128, HTB = HALF * BK * 2, STAGE_BYTES = 8 * HTB, NXCD = 8, WGM = 8;
__host__ __device__ __forceinline__ int lds_byte(int r, int c) { const int st = (r >> 4) * 2 + (c >> 5), rr = r & 15, cc = c & 31, ob = rr * 64 + cc * 2; return st * 1024 + (ob ^ (((ob >> 9) & 1) << 5)); }
__host__ __device__ __forceinline__ void stage_rc(int b, int& R, int& C) { const int st = b / 1024, sb = b % 1024, swz = sb ^ (((sb >> 9) & 1) << 5); R = (st >> 1) * 16 + swz / 64; C = (st & 1) * 32 + (swz % 64) / 2; }
__host__ __device__ __forceinline__ int perm32(int rho) { const int n = rho >> 4, i = rho & 15; return 8 * (i >> 2) + 4 * n + (i & 3); }

struct Unit { int pm, pn; };
struct Gemm { const bf16_t* A; const bf16_t* Bt; int M, N, K, lda; };

struct StaticOrder {
    int nM, nN, nwg, G, c;
    __device__ void init(int M_, int N_, int G_, int c_) { nM = M_ / BM; nN = N_ / BM; nwg = nM * nN; G = G_; c = c_; }
    __device__ bool next(int i, Unit& u) const {
        const long L = (long)i * G + c; if (L >= nwg) return false;
        int wgid = (int)L; { const int q = nwg / NXCD, r = nwg % NXCD, xcd = wgid % NXCD, off = wgid / NXCD; wgid = (xcd < r ? xcd * (q + 1) : r * (q + 1) + (xcd - r) * q) + off; }
        const int nig = WGM * nN, gid = wgid / nig, fm = gid * WGM, gsz = (nM - fm) < WGM ? (nM - fm) : WGM;
        u.pm = fm + ((wgid % nig) % gsz); u.pn = (wgid % nig) / gsz; return true;
    }
};


template <int NP> __device__ __forceinline__ float row_ss(const float* ss, int row) {
    if (NP == 1) return ss[row];
    const f32x4* p = (const f32x4*)(ss + (size_t)row * 16);
    const f32x4 a = p[0], b = p[1], c = p[2], d = p[3];
    return ((a[0] + a[1]) + (a[2] + a[3])) + ((b[0] + b[1]) + (b[2] + b[3])) + ((c[0] + c[1]) + (c[2] + c[3])) + ((d[0] + d[1]) + (d[2] + d[3]));
}
__device__ __forceinline__ float row_ss16_coop(const float* ss, int row, int fq) {
    const f32x4 a = *(const GAS f32x4*)(ss + (size_t)row * 16 + 4 * fq);
    float s = (a[0] + a[1]) + (a[2] + a[3]);
    s += __shfl_xor(s, 16); s += __shfl_xor(s, 32);
    return s;
}
template <int NP> struct EpiSwiGLU {
    bf16_t* H; const float* ss;
    __device__ __forceinline__ void operator()(const f32x4 (&acc)[2][2][4][2], const Unit& u, int wr, int wc, int fr, int fq) const {
        const int row0 = u.pm * BM + wr * 64 + fr, col0 = u.pn * 128 + wc * 32 + 8 * fq;
        float rsv[8];
#pragma unroll
        for (int i = 0; i < 8; ++i) rsv[i] = (NP == 16) ? row_ss16_coop(ss, row0 + (i >> 2) * HALF + (i & 3) * 16, fq) : row_ss<1>(ss, row0 + (i >> 2) * HALF + (i & 3) * 16);
#pragma unroll
        for (int i = 0; i < 8; ++i) rsv[i] = __builtin_amdgcn_rsqf(rsv[i] * (1.0f / 1024.0f) + EPS);
#pragma unroll
        for (int ai = 0; ai < 2; ++ai)
#pragma unroll
            for (int m = 0; m < 4; ++m) {
                const int row = row0 + ai * HALF + m * 16;
                const float rs = rsv[ai * 4 + m];
                float h[8];
#pragma unroll
                for (int n = 0; n < 2; ++n)
#pragma unroll
                    for (int i = 0; i < 4; ++i) {
                        const float g = acc[ai][0][m][n][i] * rs, uu = acc[ai][1][m][n][i] * rs;
                        const float e = __builtin_amdgcn_exp2f(-g * LOG2E);
                        h[n * 4 + i] = g * __builtin_amdgcn_rcpf(1.0f + e) * uu;
                    }
                u32x4 w; w.x = cvt_pk_bf16(h[0], h[1]); w.y = cvt_pk_bf16(h[2], h[3]); w.z = cvt_pk_bf16(h[4], h[5]); w.w = cvt_pk_bf16(h[6], h[7]);
                *(GAS u32x4*)(H + (size_t)row * FF + col0) = w;
                asm volatile("" ::: "memory");
            }
    }
};

template <bool WRITE_SS> struct EpiResid {
    bf16_t* xb; float* ss; float alpha;
    __device__ __forceinline__ void operator()(const f32x4 (&acc)[2][2][4][2], const Unit& u, int wr, int wc, int fr, int fq) const {
        const int row0 = u.pm * BM + wr * 64 + fr, col0 = u.pn * BM + wc * 32 + 8 * fq;
#pragma unroll
        for (int ai = 0; ai < 2; ++ai) {
            u32x4 old[4][2];
#pragma unroll
            for (int i = 0; i < 4; ++i)
#pragma unroll
                for (int bj = 0; bj < 2; ++bj) old[i][bj] = *(const GAS u32x4*)(xb + (size_t)(row0 + ai * HALF + i * 16) * D + col0 + bj * HALF);
#pragma unroll
            for (int m = 0; m < 4; ++m) {
                const int row = row0 + ai * HALF + m * 16;
                bf16_t* xr = xb + (size_t)row * D + col0;
                float sq = 0.f;
#pragma unroll
                for (int bj = 0; bj < 2; ++bj) {
                    const u32x4 o = old[m][bj];
                    f32x4 a = {__uint_as_float(o.x << 16), __uint_as_float(o.x & 0xffff0000u), __uint_as_float(o.y << 16), __uint_as_float(o.y & 0xffff0000u)};
                    f32x4 b = {__uint_as_float(o.z << 16), __uint_as_float(o.z & 0xffff0000u), __uint_as_float(o.w << 16), __uint_as_float(o.w & 0xffff0000u)};
                    a = a + acc[ai][bj][m][0] * alpha; b = b + acc[ai][bj][m][1] * alpha;
                    if (WRITE_SS) sq += (a[0] * a[0] + a[1] * a[1]) + (a[2] * a[2] + a[3] * a[3]) + (b[0] * b[0] + b[1] * b[1]) + (b[2] * b[2] + b[3] * b[3]);
                    u32x4 w; w.x = cvt_pk_bf16(a[0], a[1]); w.y = cvt_pk_bf16(a[2], a[3]); w.z = cvt_pk_bf16(b[0], b[1]); w.w = cvt_pk_bf16(b[2], b[3]);
                    *(GAS u32x4*)(xr + bj * HALF) = w;
                }
                if (WRITE_SS) { sq += __shfl_xor(sq, 16); sq += __shfl_xor(sq, 32); if (fq == 0) ss[(size_t)row * 16 + u.pn * 4 + wc] = sq; }
            }
            asm volatile("" ::: "memory");
        }
    }
};

struct EpiWin {
    bf16_t* P; const float* ss; const float *dqn, *dkn, *lqn, *lkn;
    __device__ __forceinline__ void operator()(const f32x4 (&acc)[2][2][4][2], const Unit& u, int wr, int wc, int fr, int fq) const {
        const int g64 = 4 * u.pn + wc;
        const int row0 = u.pm * BM + wr * 64 + fr, col0 = 64 * g64 + 8 * fq;
        int type = 0; const float* gn = dqn; float sc = 1.f;
        if (g64 >= 6 && g64 < 10) { type = 1; gn = dqn; sc = 0.17677669529663687f * LOG2E; }
        else if (g64 >= 28 && g64 < 32) { type = 1; gn = dkn; sc = 1.f; }
        else if (g64 >= 10 && g64 < 16) { type = 2; gn = lqn; sc = 0.125f * LOG2E; }
        else if (g64 >= 36 && g64 < 42) { type = 2; gn = lkn; sc = 1.f; }
        float gv[2][8];
#pragma unroll
        for (int bj = 0; bj < 2; ++bj)
#pragma unroll
            for (int i = 0; i < 8; ++i) gv[bj][i] = (type == 0) ? 1.f : gn[(type == 2 ? 32 * bj : 0) + 8 * fq + i] * sc;
        float rsv[8];
#pragma unroll
        for (int i = 0; i < 8; ++i) rsv[i] = row_ss16_coop(ss, row0 + (i >> 2) * HALF + (i & 3) * 16, fq);
#pragma unroll
        for (int i = 0; i < 8; ++i) rsv[i] = __builtin_amdgcn_rsqf(rsv[i] * (1.0f / 1024.0f) + EPS);
#pragma unroll
        for (int ai = 0; ai < 2; ++ai)
#pragma unroll
            for (int m = 0; m < 4; ++m) {
                const int row = row0 + ai * HALF + m * 16;
                const float rs = rsv[ai * 4 + m];
                float v[2][8]; float q[2];
#pragma unroll
                for (int bj = 0; bj < 2; ++bj) { q[bj] = 0.f;
#pragma unroll
                    for (int n = 0; n < 2; ++n)
#pragma unroll
                        for (int i = 0; i < 4; ++i) { const float t = acc[ai][bj][m][n][i] * rs; v[bj][n * 4 + i] = t; q[bj] += t * t; } }
                if (type != 0) {
                    q[0] += __shfl_xor(q[0], 16); q[0] += __shfl_xor(q[0], 32);
                    q[1] += __shfl_xor(q[1], 16); q[1] += __shfl_xor(q[1], 32);
                    float n0, n1;
                    if (type == 1) { n0 = __builtin_amdgcn_rsqf(q[0] * (1.0f / 32.0f) + EPS); n1 = __builtin_amdgcn_rsqf(q[1] * (1.0f / 32.0f) + EPS); }
                    else { n0 = n1 = __builtin_amdgcn_rsqf((q[0] + q[1]) * (1.0f / 64.0f) + EPS); }
#pragma unroll
                    for (int i = 0; i < 8; ++i) { v[0][i] *= n0 * gv[0][i]; v[1][i] *= n1 * gv[1][i]; }
                }
#pragma unroll
                for (int bj = 0; bj < 2; ++bj) {
                    u32x4 w; w.x = cvt_pk_bf16(v[bj][0], v[bj][1]); w.y = cvt_pk_bf16(v[bj][2], v[bj][3]); w.z = cvt_pk_bf16(v[bj][4], v[bj][5]); w.w = cvt_pk_bf16(v[bj][6], v[bj][7]);
                    *(GAS u32x4*)(P + (size_t)row * NIN + col0 + 32 * bj) = w;
                }
                asm volatile("" ::: "memory");
            }
    }
};

template <class Epi>
__device__ __forceinline__ void gemm_phase(LAS unsigned char* lds, const Gemm g, const StaticOrder& S, const Epi& E) {
    int tid_ = threadIdx.x; asm volatile("" : "+v"(tid_));
    const int tid = tid_, wid = __builtin_amdgcn_readfirstlane(tid >> 6), lane = tid & 63, wr = wid >> 2, wc = wid & 3, fr = lane & 15, fq = lane >> 4;
    const int K = g.K, nt = K / BK, lda = g.lda;
    unsigned voffA[2], voffB[2];
#pragma unroll
    for (int i = 0; i < 2; ++i) { int R, C; stage_rc(tid * 16 + i * 8192, R, C); const int Rb = (R & ~31) + perm32(R & 31);
        voffA[i] = (unsigned)(R * lda + C) * 2u; voffB[i] = (unsigned)(Rb * K + C) * 2u; }
    const unsigned kstep = (unsigned)(BK * 2);
    const unsigned hstepA = (unsigned)(HALF * lda * 2), hstepB = (unsigned)(HALF * K * 2);
    const size_t tstepA = 2 * (size_t)hstepA, tstepB = 2 * (size_t)hstepB;
    const unsigned ldsw = (unsigned)wid * 1024u;
    const int aoff = lds_byte(wr * 64 + fr, fq * 8), boff = lds_byte(wc * 32 + fr, fq * 8);
#define PG8_SA(b, h) (((b) * 2 + (h)) * HTB)
#define PG8_SB(b, h) ((4 + (b) * 2 + (h)) * HTB)
#define PG8_STAGE(bufoff, gbase, voff) do { _Pragma("unroll") for (int _i = 0; _i < 2; ++_i) \
        __builtin_amdgcn_global_load_lds((const unsigned*)((const char*)(gbase) + (voff)[_i]), (LAS unsigned*)(lds + (bufoff) + ldsw + _i * 8192), 16, 0, 0); } while (0)
#define PG8_LDA(dst, b, h) do { _Pragma("unroll") for (int m = 0; m < 4; ++m) _Pragma("unroll") for (int k = 0; k < 2; ++k) dst[m][k] = *(const LAS bf16x8*)(lds + PG8_SA(b, h) + aoff + m * 2048 + k * 1024); } while (0)
#define PG8_LDB(dst, b, h) do { _Pragma("unroll") for (int n = 0; n < 2; ++n) _Pragma("unroll") for (int k = 0; k < 2; ++k) dst[n][k] = *(const LAS bf16x8*)(lds + PG8_SB(b, h) + boff + n * 2048 + k * 1024); } while (0)
#define PG8_MMA(ai, bj, At, Bt) do { __builtin_amdgcn_s_setprio(1); _Pragma("unroll") for (int m = 0; m < 4; ++m) _Pragma("unroll") for (int n = 0; n < 2; ++n) _Pragma("unroll") for (int k = 0; k < 2; ++k) \
        acc[ai][bj][m][n] = __builtin_amdgcn_mfma_f32_16x16x32_bf16(Bt[n][k], At[m][k], acc[ai][bj][m][n], 0, 0, 0); __builtin_amdgcn_s_setprio(0); } while (0)
#define PG8_WAIT_V(n) asm volatile("s_waitcnt vmcnt(" #n ")" ::: "memory")
#define PG8_WAIT_L(n) asm volatile("s_waitcnt lgkmcnt(" #n ")" ::: "memory")
#define PG8_BAR __builtin_amdgcn_s_barrier()
#define PG8_SCHED __builtin_amdgcn_sched_barrier(0)
    Unit cur, nxt; int ui = 0;
    if (!S.next(0, cur)) return;
    f32x4 acc[2][2][4][2];
#pragma unroll
    for (int a = 0; a < 2; ++a)
#pragma unroll
        for (int b = 0; b < 2; ++b)
#pragma unroll
            for (int m = 0; m < 4; ++m)
#pragma unroll
                for (int n = 0; n < 2; ++n) acc[a][b][m][n] = (f32x4){0.f, 0.f, 0.f, 0.f};
    bf16x8 At[4][2], B0[2][2], B1[2][2];
    const char* cA = (const char*)g.A + (size_t)cur.pm * tstepA; const char* cB = (const char*)g.Bt + (size_t)cur.pn * tstepB;
    PG8_STAGE(PG8_SB(0, 0), cB, voffB); PG8_STAGE(PG8_SB(0, 1), cB + hstepB, voffB); PG8_STAGE(PG8_SA(0, 0), cA, voffA); PG8_STAGE(PG8_SA(0, 1), cA + hstepA, voffA);
    if (wr == 1) PG8_BAR;
    PG8_WAIT_V(2); PG8_BAR;
    PG8_STAGE(PG8_SB(1, 0), cB + kstep, voffB); PG8_STAGE(PG8_SA(1, 0), cA + kstep, voffA); PG8_STAGE(PG8_SB(1, 1), cB + hstepB + kstep, voffB);
    PG8_WAIT_V(6); PG8_BAR;
    for (;;) {
        const bool has_next = S.next(ui + 1, nxt);
        const char* nA = has_next ? (const char*)g.A + (size_t)nxt.pm * tstepA : cA; const char* nB = has_next ? (const char*)g.Bt + (size_t)nxt.pn * tstepB : cB;
        for (int t = 0; t < nt; t += 2) {
            const bool last = (t == nt - 2);
            const char* a1 = cA + (unsigned)(t + 1) * kstep;
            const char* a2 = last ? nA : cA + (unsigned)(t + 2) * kstep; const char* b2 = last ? nB : cB + (unsigned)(t + 2) * kstep;
            const char* a3 = a2 + kstep; const char* b3 = b2 + kstep;
            PG8_LDB(B0, 0, 0); PG8_LDB(B1, 0, 1); PG8_SCHED; PG8_LDA(At, 0, 0); PG8_STAGE(PG8_SA(1, 1), a1 + hstepA, voffA);
            PG8_WAIT_V(8); PG8_WAIT_L(0); PG8_BAR; PG8_MMA(0, 0, At, B0); PG8_MMA(0, 1, At, B1); PG8_BAR; PG8_SCHED;
            PG8_LDA(At, 0, 1); PG8_STAGE(PG8_SB(0, 0), b2, voffB); PG8_STAGE(PG8_SB(0, 1), b2 + hstepB, voffB); PG8_STAGE(PG8_SA(0, 0), a2, voffA);
            PG8_WAIT_V(8); PG8_WAIT_L(0); PG8_BAR; PG8_MMA(1, 0, At, B0); PG8_MMA(1, 1, At, B1); PG8_BAR; PG8_SCHED;
            PG8_LDB(B0, 1, 0); PG8_LDB(B1, 1, 1); PG8_SCHED; PG8_LDA(At, 1, 0); PG8_STAGE(PG8_SA(0, 1), a2 + hstepA, voffA);
            PG8_WAIT_V(8); PG8_WAIT_L(0); PG8_BAR; PG8_MMA(0, 0, At, B0); PG8_MMA(0, 1, At, B1); PG8_BAR; PG8_SCHED;
            PG8_LDA(At, 1, 1); PG8_STAGE(PG8_SB(1, 0), b3, voffB); PG8_STAGE(PG8_SB(1, 1), b3 + hstepB, voffB); PG8_STAGE(PG8_SA(1, 0), a3, voffA);
            PG8_WAIT_V(8); PG8_WAIT_L(0); PG8_BAR; PG8_MMA(1, 0, At, B0); PG8_MMA(1, 1, At, B1); PG8_BAR; PG8_SCHED;
        }
        if (wr == 0) PG8_BAR;
        E(acc, cur, wr, wc, fr, fq);
        if (!has_next) break;
#pragma unroll
        for (int a = 0; a < 2; ++a)
#pragma unroll
            for (int b = 0; b < 2; ++b)
#pragma unroll
                for (int m = 0; m < 4; ++m)
#pragma unroll
                    for (int n = 0; n < 2; ++n) acc[a][b][m][n] = (f32x4){0.f, 0.f, 0.f, 0.f};
        cur = nxt; cA = nA; cB = nB; ++ui;
        if (wr == 1) PG8_BAR;
    }
    PG8_WAIT_V(0);
    PG8_BAR;
#undef PG8_SA
#undef PG8_SB
#undef PG8_STAGE
#undef PG8_LDA
#undef PG8_LDB
#undef PG8_MMA
#undef PG8_WAIT_V
#undef PG8_WAIT_L
#undef PG8_BAR
#undef PG8_SCHED
}
}

__device__ __forceinline__ int map_gu(int nb) { const int r = nb * 32, pn = r >> 8, t = r & 255, bj = t >> 7; return bj * 88 + 4 * pn + ((t & 127) >> 5); }
__device__ __forceinline__ int map_win(int nb) {
    const int r = nb * 32, pn = r >> 8, t = r & 255, bj = t >> 7, wc = (t & 127) >> 5, p = 8 * pn + 2 * wc + bj;
    if (p < 12) return 12 + p; if (p < 20) return 36 + (p - 12); if (p < 32) return 60 + (p - 20); if (p < 44) return p - 32; if (p < 56) return 24 + (p - 44);
    if (p < 64) return 44 + (p - 56); if (p < 72) return 52 + (p - 64); return p;
}
__device__ __forceinline__ void wt_item(const float* W, int K, int N, const float* gain, bf16_t* WT, int kb, int nb, int sg, LAS float* scr, int lane) {
    const int k0 = 64 * kb;
    f32x4 wv[8];
#pragma unroll
    for (int i = 0; i < 8; ++i) wv[i] = *(const GAS f32x4*)(W + (size_t)(k0 + 8 * i + (lane >> 3)) * N + 32 * sg + 4 * (lane & 7));
#pragma unroll
    for (int i = 0; i < 8; ++i) { const int kk = 8 * i + (lane >> 3); const float g = gain ? gain[k0 + kk] : 1.f; LAS float* d = scr + kk * 33 + 4 * (lane & 7);
        d[0] = wv[i][0] * g; d[1] = wv[i][1] * g; d[2] = wv[i][2] * g; d[3] = wv[i][3] * g; }
    asm volatile("s_waitcnt lgkmcnt(0)" ::: "memory");
    const int c = lane & 7;
#pragma unroll
    for (int j = 0; j < 4; ++j) { const int n = (lane >> 3) + 8 * j; const LAS float* s = scr + (8 * c) * 33 + n;
        u32x4 o; o.x = cvt_pk_bf16(s[0 * 33], s[1 * 33]); o.y = cvt_pk_bf16(s[2 * 33], s[3 * 33]); o.z = cvt_pk_bf16(s[4 * 33], s[5 * 33]); o.w = cvt_pk_bf16(s[6 * 33], s[7 * 33]);
        *(u32x4*)(WT + (size_t)(32 * nb + n) * K + k0 + 8 * c) = o; }
    asm volatile("s_waitcnt lgkmcnt(0)" ::: "memory");
}

struct Args { const float* in[23]; float* out; unsigned char* ws; };

__device__ __forceinline__ void weights_phase(const Args& a, LAS unsigned char* lds, int gw, int NGW, int wave, int lane) {
    LAS float* scr = (LAS float*)(lds + wave * 8704);
    bf16_t* Wb = (bf16_t*)(a.ws + WS_W);
    constexpr int I_GU = 16 * 176, I_D = 44 * 32, I_IN = 16 * 96, I_OUT = 16 * 32;
    constexpr int PER_LAYER = 2 * I_GU + 2 * I_D + I_IN + I_OUT;
    for (int it = gw; it < DEPTH * PER_LAYER; it += NGW) {
        const int l = it / PER_LAYER; int r = it - l * PER_LAYER;
        bf16_t* wl = Wb + (size_t)l * W_LAYER;
        if (r < I_GU) { const int kb = r / 176, nb = r % 176; wt_item(a.in[3] + (size_t)l * D * 2 * FF, D, 2 * FF, a.in[2] + l * D, wl + WO_GU1, kb, nb, map_gu(nb), scr, lane); continue; } r -= I_GU;
        if (r < I_D) { const int kb = r / 32, nb = r % 32; wt_item(a.in[4] + (size_t)l * FF * D, FF, D, nullptr, wl + WO_D1, kb, nb, nb, scr, lane); continue; } r -= I_D;
        if (r < I_IN) { const int kb = r / 96, nb = r % 96; wt_item(a.in[6] + (size_t)l * D * NIN, D, NIN, a.in[5] + l * D, wl + WO_IN, kb, nb, map_win(nb), scr, lane); continue; } r -= I_IN;
        if (r < I_OUT) { const int kb = r / 32, nb = r % 32; wt_item(a.in[17] + (size_t)l * D * D, D, D, nullptr, wl + WO_OUT, kb, nb, nb, scr, lane); continue; } r -= I_OUT;
        if (r < I_GU) { const int kb = r / 176, nb = r % 176; wt_item(a.in[19] + (size_t)l * D * 2 * FF, D, 2 * FF, a.in[18] + l * D, wl + WO_GU2, kb, nb, map_gu(nb), scr, lane); continue; } r -= I_GU;
        { const int kb = r / 32, nb = r % 32; wt_item(a.in[20] + (size_t)l * FF * D, FF, D, nullptr, wl + WO_D2, kb, nb, nb, scr, lane); }
    }
}

template <bool FIRST>
__device__ __forceinline__ void norm_phase(const float* xp, const float* xs, float* out, unsigned char* ws, int mode, const float* gain, int gw, int NGW, int lane) {
    asm volatile("" : "+v"(lane));
    bf16_t* xb = (bf16_t*)(ws + WS_XB);
    float* ss1 = (float*)(ws + WS_SS1);
    for (int m = gw; m < M; m += NGW) {
        f32x4 v[4]; float s = 0.f;
        if (FIRST) {
            const float* src = (m < SEQ ? xp + (size_t)m * D : xs + (size_t)(m - SEQ) * D);
#pragma unroll
            for (int j = 0; j < 4; ++j) v[j] = *((const GAS f32x4*)src + lane + 64 * j);
        } else {
#pragma unroll
            for (int j = 0; j < 4; ++j) { const u32x2 w = *((const GAS u32x2*)(xb + (size_t)m * D) + lane + 64 * j);
                v[j] = (f32x4){__uint_as_float(w.x << 16), __uint_as_float(w.x & 0xffff0000u), __uint_as_float(w.y << 16), __uint_as_float(w.y & 0xffff0000u)}; }
        }
#pragma unroll
        for (int j = 0; j < 4; ++j) s += (v[j][0] * v[j][0] + v[j][1] * v[j][1]) + (v[j][2] * v[j][2] + v[j][3] * v[j][3]);
        s = wave_sum(s);
        if (!FIRST) {
            const float rs = __builtin_amdgcn_rsqf(s * (1.0f / 1024.0f) + EPS); float s2 = 0.f;
#pragma unroll
            for (int j = 0; j < 4; ++j) { const f32x4 gg = *((const GAS f32x4*)gain + lane + 64 * j); v[j] = v[j] * rs * gg; s2 += (v[j][0] * v[j][0] + v[j][1] * v[j][1]) + (v[j][2] * v[j][2] + v[j][3] * v[j][3]); }
            s = wave_sum(s2);
        }
        if (mode == 2) {
#pragma unroll
            for (int j = 0; j < 4; ++j) *((GAS f32x4*)(out + (size_t)m * D) + lane + 64 * j) = v[j];
        } else {
#pragma unroll
            for (int j = 0; j < 4; ++j) { u32x2 w; w.x = cvt_pk_bf16(v[j][0], v[j][1]); w.y = cvt_pk_bf16(v[j][2], v[j][3]); *((GAS u32x2*)(xb + (size_t)m * D) + lane + 64 * j) = w; }
            if (lane == 0) ss1[m] = s;
        }
    }
}

__device__ __forceinline__ int crow(int r, int hi) { return (r & 3) + 8 * (r >> 2) + 4 * hi; }
__device__ __forceinline__ int rel_bucket(int rel) {
    const int ret = rel > 0 ? 16 : 0; const int n = rel < 0 ? -rel : rel;
    if (n < 8) return ret + n;
    const float nf = (float)n;
    int large = 8 + (int)(logf(nf / 8.0f) / 4.852030263919617f * 8.0f);
    large = large < 15 ? large : 15;
    return ret + large;
}
typedef short v4i16_t __attribute__((ext_vector_type(4)));
__device__ __forceinline__ s16x4 vtr(const LAS unsigned char* p) { return __builtin_bit_cast(s16x4, __builtin_amdgcn_ds_read_tr16_b64_v4i16((LAS v4i16_t*)p)); }
#define MFMA32(a, b, c) __builtin_amdgcn_mfma_f32_32x32x16_bf16((a), (b), (c), 0, 0, 0)

__device__ __forceinline__ void attn_setup(const float* par, int l, LAS unsigned char* lds) {
    int tid_ = threadIdx.x; asm volatile("" : "+v"(tid_));
    const int tid = tid_, lane = tid & 63, wave = tid >> 6;
    LAS float* misc = (LAS float*)(lds + MISC_OFF);
    const float* rb = par + P_RB;
    if (wave == 0) {
        const float mq = wave_max(lane < 32 ? fabsf(par[P_DQN + l * 32 + lane]) : 0.f), mk = wave_max(lane < 32 ? fabsf(par[P_DKN + l * 32 + lane]) : 0.f);
        const float mlq = wave_max(fabsf(par[P_LQN + l * 64 + lane])), mlk = wave_max(fabsf(par[P_LKN + l * 64 + lane]));
        for (int hh = 0; hh < 10; ++hh) {
            const float bm = wave_max(lane < 32 ? fabsf(rb[lane * 10 + hh]) : 0.f);
            const float B = (hh < 4 ? 1.02f * 5.656854249f * mq * mk : 1.02f * 8.0f * mlq * mlk) + bm + 0.05f;
            if (lane == 0) misc[hh] = B;
        }
        const float s1 = wave_sum(lane < 32 ? par[P_LQ1 + l * 32 + lane] * par[P_LK1 + l * 32 + lane] : 0.f);
        const float s2 = wave_sum(lane < 32 ? par[P_LQ2 + l * 32 + lane] * par[P_LK2 + l * 32 + lane] : 0.f);
        const float lam_init = 0.8f - 0.6f * expf(-0.3f * (float)l);
        if (lane == 0) { misc[16] = expf(s1) - expf(s2) + lam_init; misc[17] = 1.0f - lam_init; }
    }
    __syncthreads();
    LAS float* td = (LAS float*)(lds + TDIFF_OFF);
    for (int i = tid; i < 4 * TDIFF_STRIDE; i += 512) { const int h = i / TDIFF_STRIDE, j = i % TDIFF_STRIDE; const int d = (j < 2 * DOFF + 1 ? j : 2 * DOFF) - DOFF;
        td[i] = (rb[rel_bucket(d) * 10 + h] - misc[h]) * LOG2E; }
    LAS float* tl = (LAS float*)(lds + TDIL_OFF);
    for (int i = tid; i < 6 * TDIL_STRIDE; i += 512) { const int hd = i / TDIL_STRIDE, j = i % TDIL_STRIDE; const int b = j < 1152 ? 0 : (j < 1560 ? 1 : 2), jj = j - (b == 0 ? 0 : (b == 1 ? 1152 : 1560));
        const int r = (b == 0) ? 1 : (b == 1 ? 4 : 16), f = 16 / r, mm = jj - (64 + 31 * f);
        tl[i] = (mm >= -64 && mm <= 64) ? (rb[rel_bucket(r * mm) * 10 + 4 + hd] - misc[4 + hd]) * LOG2E : -1e30f; }
    __syncthreads();
}

__device__ __forceinline__ void diff_unit(LAS unsigned char* lds, bf16_t* proj, const float* subg, int seq, int h, int qb, float lam, float osc) {
    int tid_ = threadIdx.x; asm volatile("" : "+v"(tid_));
    const int tid = tid_, lane = tid & 63, r32 = lane & 31, hi = lane >> 5, wid = __builtin_amdgcn_readfirstlane(tid >> 6);
    const size_t rowbase = (size_t)seq * SEQ;
    const int qw = qb * 256 + wid * 32;
    const bf16_t* Kg = proj + rowbase * NIN + PC_DK + h * 64;
    const bf16_t* Vg = proj + rowbase * NIN + PC_DV + h * 64;
    bf16_t* Qg = proj + (rowbase + qw) * NIN + PC_DQ + h * 64;
    bf16x8 qr[4];
#pragma unroll
    for (int j = 0; j < 4; ++j) qr[j] = *(const GAS bf16x8*)(Qg + (size_t)r32 * NIN + 16 * j + 8 * hi);
    const bf16_t* ksrc = Kg + (size_t)lane * NIN + wid * 8;
    const bf16_t* vsrc = Vg + (size_t)(16 * (wid & 3) + (lane >> 2)) * NIN + (wid >> 2) * 32 + (lane & 3) * 8;
    LAS unsigned char* kdst = lds + wid * 2048 + lane * 16;
    LAS unsigned char* vdst = lds + 32768 + (wid >> 2) * 8192 + (wid & 3) * 1024 + lane * 16;
    const LAS unsigned char* kp0 = lds + hi * 2048 + r32 * 16;
    const LAS unsigned char* vp0 = lds + 32768 + ((lane >> 4) & 1) * 32 + (lane & 3) * 8 + (4 * hi + ((lane & 15) >> 2)) * 64;
    const LAS float* Tb = (const LAS float*)(lds + TDIFF_OFF) + h * TDIFF_STRIDE;
    const float cL = Tb[0], cR = Tb[2 * DOFF];
    constexpr int NT = SEQ / 128;
    u32x4 kreg = *(const GAS u32x4*)ksrc, vreg = *(const GAS u32x4*)vsrc;
    *(LAS u32x4*)kdst = kreg; *(LAS u32x4*)vdst = vreg;
    kreg = *(const GAS u32x4*)(ksrc + (size_t)64 * NIN); vreg = *(const GAS u32x4*)(vsrc + (size_t)64 * NIN);
    *(LAS u32x4*)(kdst + 1024) = kreg; *(LAS u32x4*)(vdst + 4096) = vreg;
    __syncthreads();
    f32x16 o00 = {}, o01 = {}, o10 = {}, o11 = {};
    float l0 = 0.f, l1 = 0.f;
#define DIFF_EXP(SA, SB, PP, LL) do { float a0 = 0.f, a1 = 0.f; \
        _Pragma("unroll") for (int r = 0; r < 16; ++r) { SA[r] = __builtin_amdgcn_exp2f(SA[r]); SB[r] = __builtin_amdgcn_exp2f(SB[r]); a0 += SA[r]; a1 += SB[r]; } \
        LL += a0 + a1; \
        _Pragma("unroll") for (int i = 0; i < 4; ++i) { \
            PP[0][i] = cvt_pk_bf16(SA[2 * i], SA[2 * i + 1]); PP[1][i] = cvt_pk_bf16(SA[8 + 2 * i], SA[9 + 2 * i]); \
            PP[2][i] = cvt_pk_bf16(SB[2 * i], SB[2 * i + 1]); PP[3][i] = cvt_pk_bf16(SB[8 + 2 * i], SB[9 + 2 * i]); } } while (0)
#define DIFF_SUB(NEAR, H) do { \
        if (t + 1 < NT) { const size_t go = (size_t)((t + 1) * 128 + 64 * (H)) * NIN; kreg = *(const GAS u32x4*)(ksrc + go); vreg = *(const GAS u32x4*)(vsrc + go); }     \
        bf16x8 kf[8]; \
        _Pragma("unroll") for (int j = 0; j < 4; ++j) { kf[2 * j] = *(const LAS bf16x8*)(kp0 + slot + j * 4096 + (H) * 1024); kf[2 * j + 1] = *(const LAS bf16x8*)(kp0 + slot + j * 4096 + (H) * 1024 + 512); } \
        f32x16 sa0, sb0, sa1, sb1; \
        if (NEAR) { \
            const LAS float* tp = Tb + (t * 128 + 64 * (H) - qw - r32 + 4 * hi + DOFF); \
            f32x16 c0, c1; \
            _Pragma("unroll") for (int r = 0; r < 16; ++r) { c0[r] = tp[(r & 3) + 8 * (r >> 2)]; c1[r] = tp[32 + (r & 3) + 8 * (r >> 2)]; } \
            sa0 = MFMA32(kf[0], qr[0], c0); sb0 = MFMA32(kf[1], qr[0], c1); sa1 = MFMA32(kf[4], qr[2], c0); sb1 = MFMA32(kf[5], qr[2], c1); \
        } else { \
            const f32x16 z = {}; \
            sa0 = MFMA32(kf[0], qr[0], z); sb0 = MFMA32(kf[1], qr[0], z); sa1 = MFMA32(kf[4], qr[2], z); sb1 = MFMA32(kf[5], qr[2], z); \
        } \
        sa0 = MFMA32(kf[2], qr[1], sa0); sb0 = MFMA32(kf[3], qr[1], sb0); sa1 = MFMA32(kf[6], qr[3], sa1); sb1 = MFMA32(kf[7], qr[3], sb1); \
        u32x4 p0[4], p1[4]; \
        DIFF_EXP(sa0, sb0, p0, l0); \
        DIFF_EXP(sa1, sb1, p1, l1); \
        _Pragma("unroll") for (int ks = 0; ks < 4; ++ks) { \
            const LAS unsigned char* vq = vp0 + slot + (4 * (H) + ks) * 1024; \
            const s16x4 lo0 = vtr(vq), hi0 = vtr(vq + 512), lo1 = vtr(vq + 8192), hi1 = vtr(vq + 8192 + 512); \
            const bf16x8 v0 = (bf16x8){lo0[0], lo0[1], lo0[2], lo0[3], hi0[0], hi0[1], hi0[2], hi0[3]}; \
            const bf16x8 v1 = (bf16x8){lo1[0], lo1[1], lo1[2], lo1[3], hi1[0], hi1[1], hi1[2], hi1[3]}; \
            const bf16x8 pa0 = __builtin_bit_cast(bf16x8, p0[ks]), pa1 = __builtin_bit_cast(bf16x8, p1[ks]); \
            o00 = MFMA32(pa0, v0, o00); o01 = MFMA32(pa0, v1, o01); o10 = MFMA32(pa1, v0, o10); o11 = MFMA32(pa1, v1, o11); } \
        if (t + 1 < NT) { const int so = slot ^ 16384; *(LAS u32x4*)(kdst + so + (H) * 1024) = kreg; *(LAS u32x4*)(vdst + so + (H) * 4096) = vreg; } \
    } while (0)
#define DIFF_STEP(NEAR) do { \
        const int slot = (t & 1) * 16384; \
        _Pragma("unroll 1") for (int H = 0; H < 2; ++H) DIFF_SUB(NEAR, H); \
        __syncthreads(); \
    } while (0)
    int nL = (qw >= 686) ? ((qw - 686) >> 7) + 1 : 0, nR = (qw + 590 + 127) >> 7; nR = nR > NT ? NT : nR;
    int t = 0;
#pragma unroll 1
    for (; t < nL; ++t) DIFF_STEP(false);
    { const float f = __builtin_amdgcn_exp2f(cL); l0 *= f; l1 *= f;
#pragma unroll
      for (int r = 0; r < 16; ++r) { o00[r] *= f; o01[r] *= f; o10[r] *= f; o11[r] *= f; } }
#pragma unroll 1
    for (; t < nR; ++t) DIFF_STEP(true);
    { const float f = __builtin_amdgcn_exp2f(-cR); l0 *= f; l1 *= f;
#pragma unroll
      for (int r = 0; r < 16; ++r) { o00[r] *= f; o01[r] *= f; o10[r] *= f; o11[r] *= f; } }
#pragma unroll 1
    for (; t < NT; ++t) DIFF_STEP(false);
#undef DIFF_STEP
#undef DIFF_SUB
#undef DIFF_EXP
    l0 += __shfl_xor(l0, 32); l1 += __shfl_xor(l1, 32);
    const float g0 = subg[r32] * osc, g1 = subg[r32 + 32] * osc;
    LAS bf16_t* stg = (LAS bf16_t*)(lds + (wid < 4 ? 16384 : 49152) + (wid & 3) * 4096);
#pragma unroll
    for (int r = 0; r < 16; ++r) {
        const int row = crow(r, hi);
        const float i0 = __builtin_amdgcn_rcpf(__shfl(l0, row)), i1 = lam * __builtin_amdgcn_rcpf(__shfl(l1, row));
        const float va = o00[r] * i0 - o10[r] * i1, vb = o01[r] * i0 - o11[r] * i1;
        float q = va * va + vb * vb;
        q += __shfl_xor(q, 1); q += __shfl_xor(q, 2); q += __shfl_xor(q, 4); q += __shfl_xor(q, 8); q += __shfl_xor(q, 16);
        const float nr = __builtin_amdgcn_rsqf(q * (1.0f / 64.0f) + EPS);
        stg[row * 64 + r32] = (bf16_t)(cvt_pk_bf16(va * nr * g0, 0.f) & 0xffffu);
        stg[row * 64 + r32 + 32] = (bf16_t)(cvt_pk_bf16(vb * nr * g1, 0.f) & 0xffffu);
    }
    asm volatile("s_waitcnt lgkmcnt(0)" ::: "memory");
#pragma unroll
    for (int i = 0; i < 4; ++i) { const int row = i * 8 + (lane >> 3), ch = lane & 7; const u32x4 v = *(const LAS u32x4*)(stg + row * 64 + ch * 8); *(GAS u32x4*)(Qg + (size_t)row * NIN + ch * 8) = v; }
}

__device__ __forceinline__ void dil_unit(LAS unsigned char* lds, bf16_t* proj, int seq, int hd, int T0, int rho) {
    int tid_ = threadIdx.x; asm volatile("" : "+v"(tid_));
    const int tid = tid_, lane = tid & 63, r32 = lane & 31, hi = lane >> 5, wid = __builtin_amdgcn_readfirstlane(tid >> 6);
    bf16_t* base = proj + (size_t)seq * SEQ * NIN;
    LAS unsigned char* wbuf = lds + wid * 4096;
    const LAS unsigned char* vp = wbuf + ((lane >> 4) & 1) * 32 + (lane & 3) * 8 + (4 * hi + ((lane & 15) >> 2)) * 64;
    const int P0 = T0 + rho;
    bf16x8 qr[4];
#pragma unroll
    for (int ks = 0; ks < 4; ++ks) qr[ks] = *(const GAS bf16x8*)(base + (size_t)(P0 + 16 * r32) * NIN + PC_LQ + hd * 64 + 16 * ks + 8 * hi);
    f32x16 o0 = {}, o1 = {}; float l = 0.f;
    const bool bound = (T0 < 1024) || (T0 >= 15360);
#define DIL_PARAMS(i_) const int b_ = ((i_) >= 28) ? 2 : ((i_) >= 20 ? 1 : 0), g_ = (i_) - (b_ == 2 ? 28 : (b_ == 1 ? 20 : 0)), r_ = (b_ == 0) ? 1 : (b_ == 1 ? 4 : 16), kap0_ = 32 * g_ - 64
#define DIL_CLAMP(BOUND, x) ((BOUND) ? ((x) < 0 ? 0 : ((x) > SEQ - 1 ? SEQ - 1 : (x))) : (x))
#define DIL_LOADS(BOUND, i_, KF, VR) do { DIL_PARAMS(i_); \
        const int kpos = DIL_CLAMP(BOUND, P0 + r_ * (kap0_ + r32)); \
        _Pragma("unroll") for (int ks = 0; ks < 4; ++ks) KF[ks] = *(const GAS bf16x8*)(base + (size_t)kpos * NIN + PC_LK + hd * 64 + 16 * ks + 8 * hi); \
        _Pragma("unroll") for (int w = 0; w < 4; ++w) { const int vpos = DIL_CLAMP(BOUND, P0 + r_ * (kap0_ + 16 * (w & 1) + (lane >> 2))); \
            VR[w] = *(const GAS u32x4*)(base + (size_t)vpos * NIN + PC_LV + hd * 64 + (w >> 1) * 32 + (lane & 3) * 8); } } while (0)
#define DIL_LOOP(BOUND) do { \
    bf16x8 kfn[4]; u32x4 vrn[4]; \
    DIL_LOADS(BOUND, 0, kfn, vrn); \
    _Pragma("unroll 1") for (int i = 0; i < 33; ++i) { \
        bf16x8 kf[4]; u32x4 vr[4]; \
        _Pragma("unroll") for (int k = 0; k < 4; ++k) { kf[k] = kfn[k]; vr[k] = vrn[k]; } \
        { const int in_ = (i + 1 < 33) ? i + 1 : 32; DIL_LOADS(BOUND, in_, kfn, vrn); } \
        DIL_PARAMS(i); \
        const int f = 16 / r_; \
        const LAS float* tp = (const LAS float*)(lds + TDIL_OFF) + hd * TDIL_STRIDE + (b_ == 0 ? 0 : (b_ == 1 ? 1152 : 1560)) + (64 + 31 * f + 4 * hi - f * r32) + kap0_; \
        _Pragma("unroll") for (int w = 0; w < 4; ++w) *(LAS u32x4*)(wbuf + w * 1024 + lane * 16) = vr[w]; \
        f32x16 sc; \
        _Pragma("unroll") for (int rr = 0; rr < 16; ++rr) sc[rr] = tp[(rr & 3) + 8 * (rr >> 2)]; \
        _Pragma("unroll") for (int ks = 0; ks < 4; ++ks) sc = MFMA32(kf[ks], qr[ks], sc); \
        float p[16]; float a0 = 0.f, a1 = 0.f; \
        _Pragma("unroll") for (int rr = 0; rr < 16; rr += 2) { \
            float e0 = __builtin_amdgcn_exp2f(sc[rr]), e1 = __builtin_amdgcn_exp2f(sc[rr + 1]); \
            if (BOUND) { const int p0_ = P0 + r_ * (kap0_ + crow(rr, hi)), p1_ = P0 + r_ * (kap0_ + crow(rr + 1, hi)); e0 = (p0_ >= 0 && p0_ < SEQ) ? e0 : 0.f; e1 = (p1_ >= 0 && p1_ < SEQ) ? e1 : 0.f; } \
            p[rr] = e0; p[rr + 1] = e1; a0 += e0; a1 += e1; } \
        l += a0 + a1; \
        u32x4 pw0, pw1; \
        _Pragma("unroll") for (int k = 0; k < 4; ++k) { pw0[k] = cvt_pk_bf16(p[2 * k], p[2 * k + 1]); pw1[k] = cvt_pk_bf16(p[8 + 2 * k], p[9 + 2 * k]); } \
        asm volatile("s_waitcnt lgkmcnt(0)" ::: "memory"); \
        _Pragma("unroll") for (int ks = 0; ks < 2; ++ks) { \
            const s16x4 lo0 = vtr(vp + ks * 1024), hi0 = vtr(vp + ks * 1024 + 512); \
            const s16x4 lo1 = vtr(vp + 2048 + ks * 1024), hi1 = vtr(vp + 2048 + ks * 1024 + 512); \
            const bf16x8 v0 = (bf16x8){lo0[0], lo0[1], lo0[2], lo0[3], hi0[0], hi0[1], hi0[2], hi0[3]}; \
            const bf16x8 v1 = (bf16x8){lo1[0], lo1[1], lo1[2], lo1[3], hi1[0], hi1[1], hi1[2], hi1[3]}; \
            const bf16x8 pa = __builtin_bit_cast(bf16x8, ks == 0 ? pw0 : pw1); \
            o0 = MFMA32(pa, v0, o0); o1 = MFMA32(pa, v1, o1); } \
        asm volatile("s_waitcnt lgkmcnt(0)" ::: "memory"); \
    } } while (0)
    if (bound) DIL_LOOP(true); else DIL_LOOP(false);
#undef DIL_LOOP
#undef DIL_CLAMP
#undef DIL_LOADS
#undef DIL_PARAMS
    LAS bf16_t* stg = (LAS bf16_t*)wbuf;
    l += __shfl_xor(l, 32);
#pragma unroll
    for (int rr = 0; rr < 16; ++rr) {
        const int j = crow(rr, hi);
        const float il = __builtin_amdgcn_rcpf(__shfl(l, j));
        stg[j * 64 + r32] = (bf16_t)(cvt_pk_bf16(o0[rr] * il, 0.f) & 0xffffu);
        stg[j * 64 + r32 + 32] = (bf16_t)(cvt_pk_bf16(o1[rr] * il, 0.f) & 0xffffu);
    }
    asm volatile("s_waitcnt lgkmcnt(0)" ::: "memory");
#pragma unroll
    for (int i = 0; i < 4; ++i) { const int row = i * 8 + (lane >> 3), ch = lane & 7; const u32x4 v = *(const LAS u32x4*)(stg + row * 64 + ch * 8);
        *(GAS u32x4*)(base + (size_t)(P0 + 16 * row) * NIN + PC_LQ + hd * 64 + ch * 8) = v; }
    asm volatile("s_waitcnt lgkmcnt(0)" ::: "memory");
}

__device__ __forceinline__ void conv_phase(bf16_t* proj, const float* cw, int G) {
    int tid_ = threadIdx.x; asm volatile("" : "+v"(tid_));
    for (int item = blockIdx.x * 512 + tid_; item < M * 48; item += G * 512) {
        const int row = item / 48, ch = (item % 48) * 8, t = row % SEQ;
        const bf16_t* pr = proj + (size_t)row * NIN;
        float accv[8];
#pragma unroll
        for (int i = 0; i < 8; ++i) accv[i] = 0.f;
#pragma unroll
        for (int k = 0; k < 3; ++k) {
            const int tt = t + k - 1;
            if (tt < 0 || tt >= SEQ) continue;
            const bf16_t* p2 = pr + (ptrdiff_t)(k - 1) * NIN;
            const u32x4 uu = *(const u32x4*)(p2 + PC_U + ch), cc = *(const u32x4*)(p2 + PC_CG + ch);
            const f32x4 w0 = *(const f32x4*)(cw + k * 384 + ch), w1 = *(const f32x4*)(cw + k * 384 + ch + 4);
#pragma unroll
            for (int i = 0; i < 4; ++i) {
                const float ulo = __uint_as_float(uu[i] << 16), uhi = __uint_as_float(uu[i] & 0xffff0000u);
                const float clo = __uint_as_float(cc[i] << 16), chi = __uint_as_float(cc[i] & 0xffff0000u);
                const float wlo = (i < 2) ? w0[2 * i] : w1[2 * i - 4], whi = (i < 2) ? w0[2 * i + 1] : w1[2 * i - 3];
                accv[2 * i] += wlo * ulo * clo; accv[2 * i + 1] += whi * uhi * chi;
            }
        }
        const u32x4 bb = *(const u32x4*)(pr + PC_BG + ch);
        u32x4 o;
#pragma unroll
        for (int i = 0; i < 4; ++i) { const float blo = __uint_as_float(bb[i] << 16), bhi = __uint_as_float(bb[i] & 0xffff0000u); o[i] = cvt_pk_bf16(blo * accv[2 * i], bhi * accv[2 * i + 1]); }
        *(u32x4*)(proj + (size_t)row * NIN + PC_BG + ch) = o;
    }
}

__device__ __forceinline__ void attn_phase(unsigned char* ws, int l, LAS unsigned char* lds, int G) {
    bf16_t* proj = (bf16_t*)(ws + WS_R);
    const float* par = (const float*)(ws + WS_PAR);
    attn_setup(par, l, lds);
    const LAS float* misc = (const LAS float*)(lds + MISC_OFF);
    const float lam = misc[16], osc = misc[17];
    const int wid = __builtin_amdgcn_readfirstlane(threadIdx.x >> 6);
    const int bx = blockIdx.x;
    const int vb = (G % 8 == 0) ? (bx % 8) * (G / 8) + bx / 8 : bx;
    for (int u = vb; u < 768; u += G) {
        const int pair = u >> 6, qb = u & 63;
        diff_unit(lds, proj, par + P_SUBN + l * 64, pair >> 2, pair & 3, qb, lam, osc);
    }
    __syncthreads();
    for (int bu = vb; bu < 1152; bu += G) {
        const int sh = bu >> 6, rem = bu & 63, T0 = (rem >> 1) * 512, rho = (rem & 1) * 8 + wid;
        dil_unit(lds, proj, sh / 6, sh % 6, T0, rho);
    }
    conv_phase(proj, par + P_CONV + l * 3 * 384, G);
}


#define XB_TMO      128
#define XB_XCNT(j)  (256  + 64 * (j))
#define XB_XSUB(j)  (1280 + 64 * (j))
#define XB_XGEN(j)  (2304 + 64 * (j))
#define XB_TOP      3328
#define XB_TOPGEN   3392
#define XB_SPIN_CAP (1u << 22)
__device__ __forceinline__ unsigned xb_ld(unsigned* p)              { return __hip_atomic_load(p, __ATOMIC_RELAXED, __HIP_MEMORY_SCOPE_AGENT); }
__device__ __forceinline__ unsigned xb_add(unsigned* p, unsigned v) { return __hip_atomic_fetch_add(p, v, __ATOMIC_RELAXED, __HIP_MEMORY_SCOPE_AGENT); }
__device__ __forceinline__ unsigned xb_xcc_id() { return (unsigned)__builtin_amdgcn_s_getreg((3 << 11) | 20) & 0xFu; }
#define XB_SPIN(cond, bar) do { unsigned _sp = 0; while (cond) { __builtin_amdgcn_s_sleep(1); \
    if ((++_sp & 255u) == 0u) { if (xb_ld(&(bar)[XB_TMO])) break; if (_sp > XB_SPIN_CAP) { atomicAdd(&(bar)[XB_TMO], 1u); break; } } } } while (0)
struct XcdBarrier { unsigned* bar; unsigned x; volatile LAS unsigned* st; };
__device__ __forceinline__ XcdBarrier xcd_barrier_post(unsigned* bar, volatile LAS unsigned* st) {
    XcdBarrier b; b.bar = bar; b.x = xb_xcc_id(); b.st = st;
    if (threadIdx.x == 0) (void)xb_add(&bar[XB_XCNT(b.x)], 1u);
    return b;
}
__device__ __forceinline__ void xcd_barrier_complete(unsigned* bar, unsigned x, unsigned& nloc, unsigned& nx) {
    const unsigned G = gridDim.x * gridDim.y * gridDim.z;
    unsigned sum, cnt, mine, sp = 0u;
    for (;;) {
        sum = 0u; cnt = 0u; mine = 0u;
#pragma unroll
        for (unsigned j = 0; j < 16; ++j) { const unsigned c = xb_ld(&bar[XB_XCNT(j)]); sum += c; cnt += (c > 0u) ? 1u : 0u; mine = (j == x) ? c : mine; }
        if (sum == G) break;
        __builtin_amdgcn_s_sleep(1);
        if ((++sp & 255u) == 0u) { if (xb_ld(&bar[XB_TMO])) break; if (sp > XB_SPIN_CAP) { atomicAdd(&bar[XB_TMO], 1u); break; } }
    }
    nloc = mine > 0u ? mine : 1u; nx = cnt > 0u ? cnt : 1u;
}
__device__ __forceinline__ void xcd_barrier(const XcdBarrier& b) {
    asm volatile("s_waitcnt vmcnt(0)" ::: "memory");
    __syncthreads();
    int t0_ = threadIdx.x; asm volatile("" : "+v"(t0_));
    if (t0_ == 0) {
        unsigned* bar = b.bar;
        __builtin_amdgcn_s_waitcnt(0);
        unsigned nloc = b.st[0], nx = b.st[1];
        if (nloc == 0u) { xcd_barrier_complete(bar, b.x, nloc, nx); b.st[0] = nloc; b.st[1] = nx; }
        const unsigned old = xb_add(&bar[XB_XSUB(b.x)], 1u);
        const unsigned gen = old / nloc;
        if (old + 1u == (gen + 1u) * nloc) {
            __builtin_amdgcn_fence(__ATOMIC_RELEASE, "agent");
            asm volatile("s_waitcnt vmcnt(0)" ::: "memory");
            const unsigned og = xb_add(&bar[XB_TOP], 1u);
            const unsigned tg = og / nx;
            if (og + 1u == (tg + 1u) * nx) xb_add(&bar[XB_TOPGEN], 1u);
            else XB_SPIN(xb_ld(&bar[XB_TOPGEN]) == tg, bar);
            __builtin_amdgcn_fence(__ATOMIC_ACQUIRE, "agent");
            xb_add(&bar[XB_XGEN(b.x)], 1u);
            asm volatile("s_waitcnt vmcnt(0)" ::: "memory");
        } else {
            XB_SPIN(xb_ld(&bar[XB_XGEN(b.x)]) == gen, bar);
            __builtin_amdgcn_fence(__ATOMIC_ACQUIRE, "agent");
            asm volatile("s_waitcnt vmcnt(0)" ::: "memory");
        }
    }
    __syncthreads();
}
__global__ void __launch_bounds__(512) mk_fwd(Args a) {
    extern __shared__ __attribute__((aligned(16))) unsigned char lds_raw[];
    LAS unsigned char* lds = (LAS unsigned char*)lds_raw;
    cg::grid_group grid = cg::this_grid();
    if (threadIdx.x < 16) ((LAS unsigned*)(lds + LDS_BAR_OFF))[threadIdx.x] = 0u;
    __syncthreads();
    (void)xcd_barrier_post((unsigned*)(a.ws + WS_CTL), (volatile LAS unsigned*)(lds + LDS_BAR_OFF));
    grid.sync();
#define GRID_SYNC() do { unsigned char* w_ = wsb; asm volatile("" : "+s"(w_)); XcdBarrier b_; b_.bar = (unsigned*)(w_ + WS_CTL); b_.x = xb_xcc_id(); \
        b_.st = (volatile LAS unsigned*)(lds + LDS_BAR_OFF); xcd_barrier(b_); } while (0)
    unsigned char* wsb = a.ws;
    const int tid = threadIdx.x, lane = tid & 63, wave = __builtin_amdgcn_readfirstlane(tid >> 6);
    const int G = gridDim.x, gw = blockIdx.x * 8 + wave, NGW = G * 8;
    weights_phase(a, lds, gw, NGW, wave, lane);
    norm_phase<true>(a.in[0], a.in[1], a.out, a.ws, 0, nullptr, gw, NGW, lane);
    if (blockIdx.x == 0) {
        float* pw = (float*)(a.ws + WS_PAR);
#define CPY(off, src, n) for (int i = tid; i < (n); i += 512) pw[(off) + i] = (src)[i]
        CPY(P_CONV, a.in[7], 2304); CPY(P_DQN, a.in[8], 64); CPY(P_DKN, a.in[9], 64); CPY(P_LQ1, a.in[10], 64); CPY(P_LK1, a.in[11], 64); CPY(P_LQ2, a.in[12], 64); CPY(P_LK2, a.in[13], 64);
        CPY(P_SUBN, a.in[14], 128); CPY(P_LQN, a.in[15], 128); CPY(P_LKN, a.in[16], 128); CPY(P_FIN, a.in[21], 2048); CPY(P_RB, a.in[22], 320);
#undef CPY
    }
    unsigned char* ws = a.ws; float* xout = a.out;
    GRID_SYNC();
    asm volatile("" : "+s"(ws), "+s"(xout));
#define PHASE_PTRS() unsigned char* w = ws; asm volatile("" : "+s"(w)); bf16_t* Wb = (bf16_t*)(w + WS_W); bf16_t* xb = (bf16_t*)(w + WS_XB); bf16_t* R = (bf16_t*)(w + WS_R); \
        float* ss1 = (float*)(w + WS_SS1); float* ss2 = (float*)(w + WS_SSP2); float* ss3 = (float*)(w + WS_SSP3); const float* par = (const float*)(w + WS_PAR); \
        const bf16_t* wl = Wb + (size_t)l * W_LAYER; pg8::StaticOrder S; (void)xb; (void)R; (void)ss1; (void)ss2; (void)ss3; (void)par; (void)wl
#define LAYER(LL) do { constexpr int l = (LL); \
        { PHASE_PTRS(); pg8::Gemm g{xb, wl + WO_GU1, M, 2 * FF, D, D}; S.init(M, 2 * FF, G, blockIdx.x); pg8::EpiSwiGLU<1> E{R, ss1}; pg8::gemm_phase(lds, g, S, E); } \
        GRID_SYNC(); \
        { PHASE_PTRS(); pg8::Gemm g{R, wl + WO_D1, M, D, FF, FF}; S.init(M, D, G, blockIdx.x); pg8::EpiResid<true> E{xb, ss2, 0.5f}; pg8::gemm_phase(lds, g, S, E); } \
        GRID_SYNC(); \
        { PHASE_PTRS(); pg8::Gemm g{xb, wl + WO_IN, M, NIN, D, D}; S.init(M, NIN, G, blockIdx.x); \
          pg8::EpiWin E{R, ss2, par + P_DQN + l * 32, par + P_DKN + l * 32, par + P_LQN + l * 64, par + P_LKN + l * 64}; pg8::gemm_phase(lds, g, S, E); } \
        GRID_SYNC(); \
        { unsigned char* w = ws; asm volatile("" : "+s"(w)); attn_phase(w, l, lds, G); } \
        GRID_SYNC(); \
        { PHASE_PTRS(); pg8::Gemm g{R, wl + WO_OUT, M, D, D, NIN}; S.init(M, D, G, blockIdx.x); pg8::EpiResid<true> E{xb, ss3, 1.0f}; pg8::gemm_phase(lds, g, S, E); } \
        GRID_SYNC(); \
        { PHASE_PTRS(); pg8::Gemm g{xb, wl + WO_GU2, M, 2 * FF, D, D}; S.init(M, 2 * FF, G, blockIdx.x); pg8::EpiSwiGLU<16> E{R, ss3}; pg8::gemm_phase(lds, g, S, E); } \
        GRID_SYNC(); \
        { PHASE_PTRS(); pg8::Gemm g{R, wl + WO_D2, M, D, FF, FF}; S.init(M, D, G, blockIdx.x); pg8::EpiResid<false> E{xb, ss3, 0.5f}; pg8::gemm_phase(lds, g, S, E); } \
        GRID_SYNC(); \
        { PHASE_PTRS(); norm_phase<false>(nullptr, nullptr, xout, w, l + 1 < DEPTH ? 1 : 2, par + P_FIN + l * D, gw, NGW, lane); } \
        if (l + 1 < DEPTH) GRID_SYNC(); \
    } while (0)
    LAYER(0);
    LAYER(1);
#undef LAYER
}

extern "C" void kernel_launch(void* const* d_in, const int* in_sizes, int n_in, void* d_out, int out_size, void* d_ws, size_t ws_size, hipStream_t stream) {
    static int grid = 0;
    if (grid == 0) {
        if (n_in != 23 || out_size != M * D || ws_size < WS_END) { fprintf(stderr, "kernel_launch: unexpected shapes (n_in %d out %d ws %zu)\n", n_in, out_size, ws_size); grid = -1; return; }
        int dev = 0, cus = 0, per_cu = 0;
        hipGetDevice(&dev);
        hipDeviceGetAttribute(&cus, hipDeviceAttributeMultiprocessorCount, dev);
        hipFuncSetAttribute((const void*)mk_fwd, hipFuncAttributeMaxDynamicSharedMemorySize, LDS_BYTES);
        hipOccupancyMaxActiveBlocksPerMultiprocessor(&per_cu, (const void*)mk_fwd, 512, LDS_BYTES);
        if (per_cu < 1) per_cu = 1;
        grid = cus * per_cu;
    }
    if (grid < 0) return;
    if (hipMemsetAsync((char*)d_ws + WS_CTL, 0, CTL_BYTES, stream) != hipSuccess) { fprintf(stderr, "memset of control words failed\n"); return; }
    Args a{};
    for (int i = 0; i < 23; ++i) a.in[i] = (const float*)d_in[i];
    a.out = (float*)d_out; a.ws = (unsigned char*)d_ws;
    void* args[] = {&a};
    hipError_t e = hipLaunchCooperativeKernel((const void*)mk_fwd, dim3(grid), dim3(512), args, LDS_BYTES, stream);
    if (e != hipSuccess) fprintf(stderr, "cooperative launch failed: %s (grid %d)\n", hipGetErrorString(e), grid);
}
```
